# Optimizing an MI355X kernel written in HIP

```python
import jax, jax.numpy as jnp
from jax import lax
import numpy as np

D_MODEL = 1024
BATCH = 16
SEQ = 2048
DEPTH = 2

MIX_WIDTH = D_MODEL
CONV_WIDTH = MIX_WIDTH // 2
SGU_WIDTH = MIX_WIDTH - CONV_WIDTH
HEAD_DIM = 64
CONV_HEADS = CONV_WIDTH // HEAD_DIM
SGU_HEADS = SGU_WIDTH // HEAD_DIM
CONV_K = 3
CHUNK = 128
IN_COLS = 3 * CONV_WIDTH + 2 * SGU_WIDTH
D_FF = ((8 * D_MODEL // 3 + 255) // 256) * 256
N_MOD = 6
EPS = 1e-6

kernel_name = "hybrid_shortconv_chunked_sgu_adaln"


def rmsnorm(x, g):
    xf = x.astype(jnp.float32)
    xf = xf * lax.rsqrt(jnp.mean(xf * xf, axis=-1, keepdims=True) + EPS)
    return xf.astype(x.dtype) * g


def short_conv_mixer(bg, cg, h, conv_w):
    z = cg * h
    zp = jnp.pad(z, ((0, 0), (CONV_K - 1, 0), (0, 0)))
    s = z.shape[1]
    conv = sum(conv_w[k] * zp[:, k:k + s, :] for k in range(CONV_K))
    return bg * conv


def chunked_sgu_mixer(u, v, v_norm, w_s, b_s):
    bsz, s, _ = u.shape
    n_chunks = s // CHUNK
    v = rmsnorm(v, v_norm)
    vc = v.reshape(bsz, n_chunks, CHUNK, SGU_HEADS, HEAD_DIM)
    mask = jnp.tril(jnp.ones((CHUNK, CHUNK), dtype=w_s.dtype))
    ws = w_s * mask[None]
    mixed = jnp.einsum('hij,bcjhd->bcihd', ws, vc)
    mixed = mixed + jnp.transpose(b_s)[None, None, :, :, None]
    return u * mixed.reshape(bsz, s, SGU_WIDTH)


def setup_inputs(seed: int = 0) -> dict:
    key = jax.random.key(seed)
    ks = jax.random.split(key, 20)
    f32 = jnp.float32
    nrm = lambda k, shape, scale: jax.random.normal(k, shape, f32) * scale
    gain = lambda k, shape: 1.0 + 0.02 * jax.random.normal(k, shape, f32)
    return {
        "x": nrm(ks[0], (BATCH, SEQ, D_MODEL), 1.0),
        "c": nrm(ks[1], (BATCH, D_MODEL), 1.0),
        "w_mod": nrm(ks[2], (DEPTH, D_MODEL, N_MOD * D_MODEL), D_MODEL ** -0.5),
        "b_mod": nrm(ks[3], (DEPTH, N_MOD * D_MODEL), 0.01),
        "norm_mix": gain(ks[4], (DEPTH, D_MODEL)),
        "w_in": nrm(ks[5], (DEPTH, D_MODEL, IN_COLS), D_MODEL ** -0.5),
        "conv_w": nrm(ks[6], (DEPTH, CONV_K, CONV_WIDTH), CONV_K ** -0.5),
        "v_norm": gain(ks[7], (DEPTH, SGU_WIDTH)),
        "w_s": nrm(ks[8], (DEPTH, SGU_HEADS, CHUNK, CHUNK), CHUNK ** -0.5),
        "b_s": gain(ks[9], (DEPTH, SGU_HEADS, CHUNK)),
        "out_norm_a": gain(ks[10], (DEPTH, CONV_WIDTH)),
        "out_norm_b": gain(ks[11], (DEPTH, SGU_WIDTH)),
        "w_out": nrm(ks[12], (DEPTH, MIX_WIDTH, D_MODEL), MIX_WIDTH ** -0.5),
        "norm_ffn": gain(ks[13], (DEPTH, D_MODEL)),
        "w_up": nrm(ks[14], (DEPTH, D_MODEL, 2 * D_FF), D_MODEL ** -0.5),
        "w_down": nrm(ks[15], (DEPTH, D_FF, D_MODEL), D_FF ** -0.5),
        "norm_final": gain(ks[16], (D_MODEL,)),
    }


def reference(x, c, w_mod, b_mod, norm_mix, w_in, conv_w, v_norm, w_s, b_s,
              out_norm_a, out_norm_b, w_out, norm_ffn, w_up, w_down, norm_final):
    c_act = jax.nn.silu(c)
    for l in range(DEPTH):
        mod = c_act @ w_mod[l] + b_mod[l]
        sh_m, sc_m, g_m, sh_f, sc_f, g_f = [m[:, None, :] for m in jnp.split(mod, N_MOD, axis=-1)]

        h = rmsnorm(x, norm_mix[l]) * (1.0 + sc_m) + sh_m
        proj = h @ w_in[l]
        bg, cg, hc, u, v = jnp.split(
            proj, np.cumsum([CONV_WIDTH, CONV_WIDTH, CONV_WIDTH, SGU_WIDTH])[:4].tolist(), axis=-1)
        y_a = short_conv_mixer(bg, cg, hc, conv_w[l])
        y_b = chunked_sgu_mixer(jax.nn.gelu(u), jax.nn.gelu(v), v_norm[l], w_s[l], b_s[l])
        y_mix = jnp.concatenate([rmsnorm(y_a, out_norm_a[l]), rmsnorm(y_b, out_norm_b[l])], axis=-1)
        x = x + g_m * (y_mix @ w_out[l])

        h = rmsnorm(x, norm_ffn[l]) * (1.0 + sc_f) + sh_f
        gate, up = jnp.split(h @ w_up[l], 2, axis=-1)
        x = x + g_f * ((jax.nn.silu(gate) * up) @ w_down[l])

    return rmsnorm(x, norm_final)
```

```cpp
#include <hip/hip_runtime.h>
#include <hip/hip_cooperative_groups.h>
#include <cstdio>
#include <cstdint>
namespace cg = cooperative_groups;
#define MK_PER_PHASE 0
#define PROBE_MASK 0
#define PROBE_LAYER 0
namespace pg8 {
#define PG8_LAS __attribute__((address_space(3)))
typedef unsigned short bf16_t;
typedef short bf16x8 __attribute__((ext_vector_type(8)));
typedef float f32x4 __attribute__((ext_vector_type(4)));
typedef unsigned u32x4 __attribute__((ext_vector_type(4)));
constexpr int BM = 256, BK = 64, HALF = 128, HTB = HALF * BK * 2  , STAGE_BYTES = 8 * HTB, NXCD = 8, WGM = 4;

__host__ __device__ __forceinline__ int lds_byte(int r, int c) { const int st = (r >> 4) * 2 + (c >> 5), rr = r & 15, cc = c & 31, ob = rr * 64 + cc * 2; return st * 1024 + (ob ^ (((ob >> 9) & 1) << 5)); }
__host__ __device__ __forceinline__ void stage_rc(int b, int& R, int& C) { const int st = b / 1024, sb = b % 1024, swz = sb ^ (((sb >> 9) & 1) << 5); R = (st >> 1) * 16 + swz / 64; C = (st & 1) * 32 + (swz % 64) / 2; }
__host__ __device__ __forceinline__ int perm32(int rho) { const int n = rho >> 4, i = rho & 15; return 8 * (i >> 2) + 4 * n + (i & 3); }

struct Unit { int pm, pn; };
struct Gemm { const bf16_t* A; const bf16_t* Bt; int M, N, K; };

struct StaticOrder {
    int nM, nN, nwg, G, c;
    __host__ __device__ void init(int M, int N, int G_, int c_) { nM = M / BM; nN = N / BM; nwg = nM * nN; G = G_; c = c_; }
    __host__ __device__ bool next(int i, Unit& u) const {
        const long L = (long)i * G + c; if (L >= nwg) return false;
        int wgid = (int)L; { const int q = nwg / NXCD, r = nwg % NXCD, xcd = wgid % NXCD, off = wgid / NXCD; wgid = (xcd < r ? xcd * (q + 1) : r * (q + 1) + (xcd - r) * q) + off; }
        const int nig = WGM * nN, gid = wgid / nig, fm = gid * WGM, gsz = (nM - fm) < WGM ? (nM - fm) : WGM;
        u.pm = fm + ((wgid % nig) % gsz); u.pn = (wgid % nig) / gsz; return true;
    }
    __device__ __forceinline__ void a_ready(const Unit&) const {}
    __device__ __forceinline__ void done(const Unit&) const {}
};


__device__ __forceinline__ unsigned cvt_pk_bf16(float lo, float hi) { unsigned r; asm volatile("v_cvt_pk_bf16_f32 %0, %1, %2" : "=v"(r) : "v"(lo), "v"(hi)); return r; }
__device__ __forceinline__ float gelu_t(float x) {
    const float u2 = x * (1.5957691216f + 0.0713548163f * x * x);
    const float e = __builtin_amdgcn_exp2f(-1.4426950409f * u2);
    return x * __builtin_amdgcn_rcpf(1.0f + e);
}
__device__ __forceinline__ float silu_f(float x) {
    const float e = __builtin_amdgcn_exp2f(-1.4426950409f * x);
    return x * __builtin_amdgcn_rcpf(1.0f + e);
}
struct EpiProj {
    static constexpr bool PERM = true, AFTER_DRAIN = false;
    bf16_t* O;
    __device__ __forceinline__ void operator()(const f32x4 (&acc)[2][2][4][2], const Unit& u, int wr, int wc, int fr, int fq) const {
        const int row0 = u.pm * BM + wr * 64 + fr; const int pn = u.pn;
        if (pn < 2) {
            const int col0 = 256 * pn + wc * 32 + 8 * fq;
#pragma unroll
            for (int ai = 0; ai < 2; ++ai)
#pragma unroll
                for (int m = 0; m < 4; ++m) { bf16_t* rowp = O + (size_t)(row0 + ai * HALF + m * 16) * 2048 + col0;
#pragma unroll
                    for (int bj = 0; bj < 2; ++bj) { const f32x4 v0 = acc[ai][bj][m][0], v1 = acc[ai][bj][m][1];
                        u32x4 w; w.x = cvt_pk_bf16(v0[0], v0[1]); w.y = cvt_pk_bf16(v0[2], v0[3]); w.z = cvt_pk_bf16(v1[0], v1[1]); w.w = cvt_pk_bf16(v1[2], v1[3]);
                        *(u32x4*)(rowp + bj * HALF) = w; } }
        } else if (pn < 6) {
            const int col0 = 512 + 128 * (pn - 2) + wc * 32 + 8 * fq;
#pragma unroll
            for (int ai = 0; ai < 2; ++ai)
#pragma unroll
                for (int m = 0; m < 4; ++m) { bf16_t* rowp = O + (size_t)(row0 + ai * HALF + m * 16) * 2048 + col0;
                    const f32x4 v0 = acc[ai][0][m][0] * acc[ai][1][m][0], v1 = acc[ai][0][m][1] * acc[ai][1][m][1];
                    u32x4 w; w.x = cvt_pk_bf16(v0[0], v0[1]); w.y = cvt_pk_bf16(v0[2], v0[3]); w.z = cvt_pk_bf16(v1[0], v1[1]); w.w = cvt_pk_bf16(v1[2], v1[3]);
                    *(u32x4*)(rowp) = w; }
        } else {
            const int col0 = 1024 + 256 * (pn - 6) + wc * 32 + 8 * fq;
#pragma unroll
            for (int ai = 0; ai < 2; ++ai)
#pragma unroll
                for (int m = 0; m < 4; ++m) { bf16_t* rowp = O + (size_t)(row0 + ai * HALF + m * 16) * 2048 + col0;
#pragma unroll
                    for (int bj = 0; bj < 2; ++bj) { const f32x4 v0 = acc[ai][bj][m][0], v1 = acc[ai][bj][m][1];
                        u32x4 w; w.x = cvt_pk_bf16(gelu_t(v0[0]), gelu_t(v0[1])); w.y = cvt_pk_bf16(gelu_t(v0[2]), gelu_t(v0[3]));
                        w.z = cvt_pk_bf16(gelu_t(v1[0]), gelu_t(v1[1])); w.w = cvt_pk_bf16(gelu_t(v1[2]), gelu_t(v1[3]));
                        *(u32x4*)(rowp + bj * HALF) = w; } }
        }
    }
};
struct EpiSwiGLU {
    static constexpr bool PERM = true, AFTER_DRAIN = false;
    bf16_t* O; int ldc;
    __device__ __forceinline__ void operator()(const f32x4 (&acc)[2][2][4][2], const Unit& u, int wr, int wc, int fr, int fq) const {
        const int row0 = u.pm * BM + wr * 64 + fr; const int col0 = 128 * u.pn + wc * 32 + 8 * fq;
#pragma unroll
        for (int ai = 0; ai < 2; ++ai)
#pragma unroll
            for (int m = 0; m < 4; ++m) { bf16_t* rowp = O + (size_t)(row0 + ai * HALF + m * 16) * ldc + col0;
                const f32x4 g0 = acc[ai][0][m][0], g1 = acc[ai][0][m][1], u0 = acc[ai][1][m][0], u1 = acc[ai][1][m][1];
                u32x4 w; w.x = cvt_pk_bf16(silu_f(g0[0]) * u0[0], silu_f(g0[1]) * u0[1]); w.y = cvt_pk_bf16(silu_f(g0[2]) * u0[2], silu_f(g0[3]) * u0[3]);
                w.z = cvt_pk_bf16(silu_f(g1[0]) * u1[0], silu_f(g1[1]) * u1[1]); w.w = cvt_pk_bf16(silu_f(g1[2]) * u1[2], silu_f(g1[3]) * u1[3]);
                *(u32x4*)(rowp) = w; }
    }
};
struct EpiRes {
    static constexpr bool PERM = false, AFTER_DRAIN = false;
    const float* base; float* out; const float* gate; int gstride;
    __device__ __forceinline__ void operator()(const f32x4 (&acc)[2][2][4][2], const Unit& u, int wr, int wc, int fr, int fq) const {
        const int row0 = u.pm * BM + wr * 64 + fr, col0 = u.pn * BM + wc * 32 + 4 * fq;
        const float* gp = gate + (size_t)(u.pm >> 3) * gstride + col0;
        f32x4 gv[2][2];
#pragma unroll
        for (int bj = 0; bj < 2; ++bj)
#pragma unroll
            for (int n = 0; n < 2; ++n) gv[bj][n] = *(const f32x4*)(gp + bj * HALF + n * 16);
#pragma unroll
        for (int ai = 0; ai < 2; ++ai)
#pragma unroll
            for (int m = 0; m < 4; ++m) { const size_t off = (size_t)(row0 + ai * HALF + m * 16) * 1024 + col0;
#pragma unroll
                for (int bj = 0; bj < 2; ++bj)
#pragma unroll
                    for (int n = 0; n < 2; ++n) { const f32x4 bs = *(const f32x4*)(base + off + bj * HALF + n * 16);
                        *(f32x4*)(out + off + bj * HALF + n * 16) = bs + gv[bj][n] * acc[ai][bj][m][n]; }
                asm volatile("" ::: "memory"); }
    }
};

template <bool BASE_F32> struct EpiResB {
    static constexpr bool PERM = true, AFTER_DRAIN = false;
    const void* base; bf16_t* out; const float* gate; int gstride;
    static __device__ __forceinline__ void unpack(const u32x4 ww, f32x4& lo, f32x4& hi) {
        lo = (f32x4){__builtin_bit_cast(float, ww.x << 16), __builtin_bit_cast(float, ww.x & 0xffff0000u), __builtin_bit_cast(float, ww.y << 16), __builtin_bit_cast(float, ww.y & 0xffff0000u)};
        hi = (f32x4){__builtin_bit_cast(float, ww.z << 16), __builtin_bit_cast(float, ww.z & 0xffff0000u), __builtin_bit_cast(float, ww.w << 16), __builtin_bit_cast(float, ww.w & 0xffff0000u)};
    }
    __device__ __forceinline__ void operator()(const f32x4 (&acc)[2][2][4][2], const Unit& u, int wr, int wc, int fr, int fq) const {
        const int row0 = u.pm * BM + wr * 64 + fr, col0 = u.pn * BM + wc * 32 + 8 * fq;
        bf16_t* op = out + (size_t)row0 * 1024 + col0;
        if (!BASE_F32) {
            const bf16_t* bp = (const bf16_t*)base + (size_t)row0 * 1024 + col0;
            u32x4 w[2][4][2];
#pragma unroll
            for (int ai = 0; ai < 2; ++ai)
#pragma unroll
                for (int m = 0; m < 4; ++m)
#pragma unroll
                    for (int bj = 0; bj < 2; ++bj) w[ai][m][bj] = *(const u32x4*)(bp + (size_t)(ai * HALF + m * 16) * 1024 + bj * HALF);
            const float* gp = gate + (size_t)(u.pm >> 3) * gstride + col0;
            f32x4 gv[2][2];
#pragma unroll
            for (int bj = 0; bj < 2; ++bj)
#pragma unroll
                for (int n = 0; n < 2; ++n) gv[bj][n] = *(const f32x4*)(gp + bj * HALF + 4 * n);
            asm volatile("" ::: "memory");
#pragma unroll
            for (int ai = 0; ai < 2; ++ai)
#pragma unroll
                for (int m = 0; m < 4; ++m)
#pragma unroll
                    for (int bj = 0; bj < 2; ++bj) {
                        f32x4 lo, hi; unpack(w[ai][m][bj], lo, hi);
                        const f32x4 v0 = lo + gv[bj][0] * acc[ai][bj][m][0], v1 = hi + gv[bj][1] * acc[ai][bj][m][1];
                        u32x4 o; o.x = cvt_pk_bf16(v0[0], v0[1]); o.y = cvt_pk_bf16(v0[2], v0[3]); o.z = cvt_pk_bf16(v1[0], v1[1]); o.w = cvt_pk_bf16(v1[2], v1[3]);
                        *(u32x4*)(op + (size_t)(ai * HALF + m * 16) * 1024 + bj * HALF) = o; }
        } else {
            const float* gp = gate + (size_t)(u.pm >> 3) * gstride + col0;
            f32x4 gv[2][2];
#pragma unroll
            for (int bj = 0; bj < 2; ++bj)
#pragma unroll
                for (int n = 0; n < 2; ++n) gv[bj][n] = *(const f32x4*)(gp + bj * HALF + 4 * n);
#pragma unroll
            for (int ai = 0; ai < 2; ++ai) {
                f32x4 b0[4][2], b1[4][2];
#pragma unroll
                for (int m = 0; m < 4; ++m)
#pragma unroll
                    for (int bj = 0; bj < 2; ++bj) { const float* bp = (const float*)base + (size_t)(row0 + ai * HALF + m * 16) * 1024 + col0 + bj * HALF;
                        b0[m][bj] = __builtin_nontemporal_load((const f32x4*)bp); b1[m][bj] = __builtin_nontemporal_load((const f32x4*)(bp + 4)); }
#pragma unroll
                for (int m = 0; m < 4; ++m)
#pragma unroll
                    for (int bj = 0; bj < 2; ++bj) {
                        const f32x4 v0 = b0[m][bj] + gv[bj][0] * acc[ai][bj][m][0], v1 = b1[m][bj] + gv[bj][1] * acc[ai][bj][m][1];
                        u32x4 o; o.x = cvt_pk_bf16(v0[0], v0[1]); o.y = cvt_pk_bf16(v0[2], v0[3]); o.z = cvt_pk_bf16(v1[0], v1[1]); o.w = cvt_pk_bf16(v1[2], v1[3]);
                        *(u32x4*)(op + (size_t)(ai * HALF + m * 16) * 1024 + bj * HALF) = o; }
                asm volatile("" ::: "memory");
            }
        }
    }
};


template <class Epi, class Sched, bool ALIGN_EPI = false, bool SP2 = false>
__device__ __forceinline__ void gemm_phase(PG8_LAS unsigned char* lds, const Gemm g, const Sched& S, const Epi& E) {
    int tid_l = threadIdx.x; asm volatile("" : "+v"(tid_l));
    const int tid = tid_l, wid = __builtin_amdgcn_readfirstlane(tid >> 6), lane = tid & 63, wr = wid >> 2, wc = wid & 3, fr = lane & 15, fq = lane >> 4;
    const int K = g.K, nt = K / BK;
    unsigned voffA[2], voffB[2];
#pragma unroll
    for (int i = 0; i < 2; ++i) { int R, C; stage_rc(tid * 16 + i * 8192, R, C); const int Rb = Epi::PERM ? ((R & ~31) + perm32(R & 31)) : R;
        voffA[i] = (unsigned)(R * K + C) * 2u; voffB[i] = (unsigned)(Rb * K + C) * 2u; }
    const size_t kstep = (size_t)(BK * 2);
    const size_t hstep = (size_t)HALF * K * 2;
    const size_t tstep = 2 * hstep;
    const unsigned ldsw = (unsigned)wid * 1024u;
    const int aoff = lds_byte(wr * 64 + fr, fq * 8), boff = lds_byte(wc * 32 + fr, fq * 8);
#define PG8_SA(b, h) (((b) * 2 + (h)) * HTB)
#define PG8_SB(b, h) ((4 + (b) * 2 + (h)) * HTB)
#define PG8_STAGE(bufoff, gbase, voff) do { _Pragma("unroll") for (int _i = 0; _i < 2; ++_i) \
        __builtin_amdgcn_global_load_lds((const unsigned*)((const char*)(gbase) + (voff)[_i]), (PG8_LAS unsigned*)(lds + (bufoff) + ldsw + _i * 8192), 16, 0, 0); } while (0)
#define PG8_LDA(dst, b, h) do { _Pragma("unroll") for (int m = 0; m < 4; ++m) _Pragma("unroll") for (int k = 0; k < 2; ++k) dst[m][k] = *(const PG8_LAS bf16x8*)(lds + PG8_SA(b, h) + aoff + m * 2048 + k * 1024); } while (0)
#define PG8_LDB(dst, b, h) do { _Pragma("unroll") for (int n = 0; n < 2; ++n) _Pragma("unroll") for (int k = 0; k < 2; ++k) dst[n][k] = *(const PG8_LAS bf16x8*)(lds + PG8_SB(b, h) + boff + n * 2048 + k * 1024); } while (0)
#define PG8_MMA(ai, bj, At, Bt) do { __builtin_amdgcn_s_setprio(1); _Pragma("unroll") for (int m = 0; m < 4; ++m) _Pragma("unroll") for (int n = 0; n < 2; ++n) _Pragma("unroll") for (int k = 0; k < 2; ++k) \
        acc[ai][bj][m][n] = __builtin_amdgcn_mfma_f32_16x16x32_bf16(Bt[n][k], At[m][k], acc[ai][bj][m][n], 0, 0, 0); __builtin_amdgcn_s_setprio(0); } while (0)
#define PG8_WAIT_V(n) asm volatile("s_waitcnt vmcnt(" #n ")" ::: "memory")
#define PG8_WAIT_L(n) asm volatile("s_waitcnt lgkmcnt(" #n ")" ::: "memory")
#define PG8_BAR __builtin_amdgcn_s_barrier()
#define PG8_SCHED __builtin_amdgcn_sched_barrier(0)
    Unit cur, nxt; int ui = 0;
    if (!S.next(0, cur)) return;
    f32x4 acc[2][2][4][2];
#pragma unroll
    for (int a = 0; a < 2; ++a)
#pragma unroll
        for (int b = 0; b < 2; ++b)
#pragma unroll
            for (int m = 0; m < 4; ++m)
#pragma unroll
                for (int n = 0; n < 2; ++n) acc[a][b][m][n] = (f32x4){0.f, 0.f, 0.f, 0.f};
    bf16x8 At[4][2], B0[2][2], B1[2][2];
    const char* cA = (const char*)g.A + (size_t)cur.pm * tstep; const char* cB = (const char*)g.Bt + (size_t)cur.pn * tstep;
    S.a_ready(cur);
    if constexpr (SP2) {
        PG8_STAGE(PG8_SB(0, 0), cB, voffB); PG8_STAGE(PG8_SB(0, 1), cB + hstep, voffB); PG8_STAGE(PG8_SA(0, 0), cA, voffA); PG8_STAGE(PG8_SA(0, 1), cA + hstep, voffA);
        if (wr == 1) PG8_BAR;
        PG8_WAIT_V(2); PG8_BAR;
        PG8_STAGE(PG8_SB(1, 0), cB + kstep, voffB); PG8_STAGE(PG8_SA(1, 0), cA + kstep, voffA); PG8_STAGE(PG8_SB(1, 1), cB + hstep + kstep, voffB);
        PG8_WAIT_V(6); PG8_BAR;
    } else {
        PG8_STAGE(PG8_SB(0, 0), cB, voffB); PG8_STAGE(PG8_SA(0, 0), cA, voffA); PG8_STAGE(PG8_SB(0, 1), cB + hstep, voffB); PG8_STAGE(PG8_SA(0, 1), cA + hstep, voffA);
        if (wr == 1) PG8_BAR;
        PG8_WAIT_V(4); PG8_BAR;
        PG8_STAGE(PG8_SB(1, 0), cB + kstep, voffB); PG8_STAGE(PG8_SA(1, 0), cA + kstep, voffA); PG8_STAGE(PG8_SB(1, 1), cB + hstep + kstep, voffB);
        PG8_WAIT_V(6); PG8_BAR;
    }
    for (;;) {
        const bool has_next = S.next(ui + 1, nxt);
        const char* nA = has_next ? (const char*)g.A + (size_t)nxt.pm * tstep : cA; const char* nB = has_next ? (const char*)g.Bt + (size_t)nxt.pn * tstep : cB;
        for (int t = 0; t < nt; t += 2) {
            const bool last = (t == nt - 2);
            const char* a1 = cA + (size_t)(t + 1) * kstep;
            const char* a2 = last ? nA : cA + (size_t)(t + 2) * kstep; const char* b2 = last ? nB : cB + (size_t)(t + 2) * kstep;
            const char* a3 = a2 + kstep; const char* b3 = b2 + kstep;
            if (last && has_next) S.a_ready(nxt);
            if constexpr (SP2) {
            PG8_LDB(B0, 0, 0); PG8_LDB(B1, 0, 1); PG8_SCHED; PG8_LDA(At, 0, 0); PG8_STAGE(PG8_SA(1, 1), a1 + hstep, voffA);
            PG8_WAIT_V(8); PG8_WAIT_L(0); PG8_BAR; PG8_MMA(0, 0, At, B0); PG8_MMA(0, 1, At, B1); PG8_BAR; PG8_SCHED;
            PG8_LDA(At, 0, 1); PG8_STAGE(PG8_SB(0, 0), b2, voffB); PG8_STAGE(PG8_SB(0, 1), b2 + hstep, voffB); PG8_STAGE(PG8_SA(0, 0), a2, voffA);
            PG8_WAIT_V(8); PG8_WAIT_L(0); PG8_BAR; PG8_MMA(1, 0, At, B0); PG8_MMA(1, 1, At, B1); PG8_BAR; PG8_SCHED;
            PG8_LDB(B0, 1, 0); PG8_LDB(B1, 1, 1); PG8_SCHED; PG8_LDA(At, 1, 0); PG8_STAGE(PG8_SA(0, 1), a2 + hstep, voffA);
            PG8_WAIT_V(8); PG8_WAIT_L(0); PG8_BAR; PG8_MMA(0, 0, At, B0); PG8_MMA(0, 1, At, B1); PG8_BAR; PG8_SCHED;
            PG8_LDA(At, 1, 1); PG8_STAGE(PG8_SB(1, 0), b3, voffB); PG8_STAGE(PG8_SB(1, 1), b3 + hstep, voffB); PG8_STAGE(PG8_SA(1, 0), a3, voffA);
            PG8_WAIT_V(8); PG8_WAIT_L(0); PG8_BAR; PG8_MMA(1, 0, At, B0); PG8_MMA(1, 1, At, B1); PG8_BAR; PG8_SCHED;
            } else {
            PG8_LDB(B0, 0, 0); PG8_SCHED; PG8_LDA(At, 0, 0); PG8_STAGE(PG8_SA(1, 1), a1 + hstep, voffA);
            PG8_WAIT_L(8); PG8_BAR; PG8_WAIT_L(0); PG8_MMA(0, 0, At, B0); PG8_BAR; PG8_SCHED;
            PG8_LDB(B1, 0, 1); PG8_STAGE(PG8_SB(0, 0), b2, voffB);
            PG8_BAR; PG8_WAIT_L(0); PG8_MMA(0, 1, At, B1); PG8_BAR;
            PG8_LDA(At, 0, 1); PG8_STAGE(PG8_SA(0, 0), a2, voffA);
            PG8_BAR; PG8_WAIT_L(0); PG8_MMA(1, 0, At, B0); PG8_BAR; PG8_SCHED;
            PG8_STAGE(PG8_SB(0, 1), b2 + hstep, voffB);
            PG8_WAIT_V(6); PG8_BAR; PG8_MMA(1, 1, At, B1); PG8_BAR;
            PG8_LDB(B0, 1, 0); PG8_SCHED; PG8_LDA(At, 1, 0); PG8_STAGE(PG8_SA(0, 1), a2 + hstep, voffA);
            PG8_WAIT_L(8); PG8_BAR; PG8_WAIT_L(0); PG8_MMA(0, 0, At, B0); PG8_BAR; PG8_SCHED;
            PG8_LDB(B1, 1, 1); PG8_STAGE(PG8_SB(1, 0), b3, voffB);
            PG8_BAR; PG8_WAIT_L(0); PG8_MMA(0, 1, At, B1); PG8_BAR;
            PG8_LDA(At, 1, 1); PG8_STAGE(PG8_SA(1, 0), a3, voffA);
            PG8_BAR; PG8_WAIT_L(0); PG8_MMA(1, 0, At, B0); PG8_BAR; PG8_SCHED;
            PG8_STAGE(PG8_SB(1, 1), b3 + hstep, voffB);
            PG8_WAIT_V(6); PG8_BAR; PG8_MMA(1, 1, At, B1); PG8_BAR;
            }
        }
        if constexpr (ALIGN_EPI) { if (wr == 0) PG8_BAR; }
        if constexpr (!Epi::AFTER_DRAIN) { E(acc, cur, wr, wc, fr, fq); S.done(cur); }
        if (!has_next) break;
#pragma unroll
        for (int a = 0; a < 2; ++a)
#pragma unroll
            for (int b = 0; b < 2; ++b)
#pragma unroll
                for (int m = 0; m < 4; ++m)
#pragma unroll
                    for (int n = 0; n < 2; ++n) acc[a][b][m][n] = (f32x4){0.f, 0.f, 0.f, 0.f};
        cur = nxt; cA = nA; cB = nB; ++ui;
        if constexpr (ALIGN_EPI) { if (wr == 1) PG8_BAR; }
    }
    PG8_WAIT_V(0);
    if constexpr (!ALIGN_EPI) { if (wr == 0) PG8_BAR; }
    PG8_BAR;
    if constexpr (Epi::AFTER_DRAIN) { E.fused(acc, cur, wr, wc, fr, fq, lds, wid, lane); S.done(cur); }
#undef PG8_SA
#undef PG8_SB
#undef PG8_STAGE
#undef PG8_LDA
#undef PG8_LDB
#undef PG8_MMA
#undef PG8_WAIT_V
#undef PG8_WAIT_L
#undef PG8_BAR
#undef PG8_SCHED
}
}

constexpr int DM = 1024, BATCH = 16, SEQ = 2048, M = BATCH * SEQ, DEPTH = 2, NIN = 2560, FF = 2816, NUP = 2 * FF, PROJW = 2048, NMOD = 6 * DM;
constexpr float EPS = 1e-6f;
constexpr int NWAVES = 8, NTHR = 512;
constexpr size_t MiB = 1u << 20;
constexpr size_t WS_WIN = 0, WS_WOUT = 10 * MiB, WS_WUP = 14 * MiB, WS_WDN = 36 * MiB, WS_WSB = 47 * MiB, WS_MOD = 48 * MiB, WS_CTL = 49 * MiB, CTL_BYTES = 16384;
constexpr size_t WS_H = 64 * MiB, WS_PROJ = 128 * MiB, WS_Y = 256 * MiB, WS_ACT = 128 * MiB  , WS_X1 = 320 * MiB, WS_END = 448 * MiB;
static_assert(WS_ACT + (size_t)M * FF * 2 <= WS_X1 && WS_PROJ + (size_t)M * PROJW * 2 <= WS_Y && WS_Y + (size_t)M * DM * 2 <= WS_X1, "ws map");
constexpr int VL_STRIDE = 68, VL_WAVE_BYTES = 128 * VL_STRIDE * 2, SSQV_OFF = 8 * VL_WAVE_BYTES, RSV_OFF = SSQV_OFF + 4096, SSQ2_OFF = RSV_OFF + 512, RSW_OFF = SSQ2_OFF + 4096  , LDS_BYTES = 152 * 1024, MISC_OFF = LDS_BYTES - 64;
static_assert(RSW_OFF + 4096 <= LDS_BYTES - 64, "lds map");

#define LAS __attribute__((address_space(3)))
typedef unsigned short bf16;
typedef unsigned v4u __attribute__((ext_vector_type(4)));
typedef unsigned v2u __attribute__((ext_vector_type(2)));
typedef float f32x4 __attribute__((ext_vector_type(4)));
typedef float f32x16 __attribute__((ext_vector_type(16)));
typedef short bf16x8 __attribute__((ext_vector_type(8)));
#define LDS_WAIT() asm volatile("s_waitcnt lgkmcnt(0)" ::: "memory")
__device__ __forceinline__ unsigned f2bf(float f) { unsigned u = __builtin_bit_cast(unsigned, f); return (u + 0x7fffu + ((u >> 16) & 1u)) >> 16; }
__device__ __forceinline__ unsigned pk2(float lo, float hi) { return f2bf(lo) | (f2bf(hi) << 16); }
__device__ __forceinline__ float bflo(unsigned w) { return __builtin_bit_cast(float, w << 16); }
__device__ __forceinline__ float bfhi(unsigned w) { return __builtin_bit_cast(float, w & 0xffff0000u); }
__device__ __forceinline__ float wave_sum(float v) {
#pragma unroll
    for (int o = 1; o < 64; o <<= 1) v += __shfl_xor(v, o);
    return v;
}

#define XB_TMO      128
#define XB_XCNT(j)  (256  + 64 * (j))
#define XB_XSUB(j)  (1280 + 64 * (j))
#define XB_XGEN(j)  (2304 + 64 * (j))
#define XB_TOP      3328
#define XB_TOPGEN   3392
#define XCD_BAR_WORDS 3456
#define XB_SPIN_CAP (1u << 18)

__device__ __forceinline__ unsigned xb_ld(unsigned* p)              { return __hip_atomic_load(p, __ATOMIC_RELAXED, __HIP_MEMORY_SCOPE_AGENT); }
__device__ __forceinline__ unsigned xb_add(unsigned* p, unsigned v) { return __hip_atomic_fetch_add(p, v, __ATOMIC_RELAXED, __HIP_MEMORY_SCOPE_AGENT); }
__device__ __forceinline__ unsigned xb_xcc_id() { return (unsigned)__builtin_amdgcn_s_getreg((3 << 11) | 20) & 0xFu; }
#define XB_SPIN(cond, bar) do { unsigned _sp = 0; while (cond) { __builtin_amdgcn_s_sleep(1); \
    if ((++_sp & 255u) == 0u) { if (xb_ld(&(bar)[XB_TMO])) break; if (_sp > XB_SPIN_CAP) { atomicAdd(&(bar)[XB_TMO], 1u); break; } } } } while (0)

struct XcdBarrier {
    unsigned* bar; unsigned x;
    volatile LAS unsigned* st;
};

__device__ __forceinline__ XcdBarrier xcd_barrier_post(unsigned* bar, volatile LAS unsigned* st) {
    XcdBarrier b; b.bar = bar; b.x = xb_xcc_id(); b.st = st;
    if (threadIdx.x == 0) (void)xb_add(&bar[XB_XCNT(b.x)], 1u);
    return b;
}
__device__ __forceinline__ void xcd_barrier_complete(unsigned* bar, unsigned x, unsigned& nloc, unsigned& nx) {
    const unsigned G = gridDim.x * gridDim.y * gridDim.z;
    unsigned sum, cnt, mine, sp = 0u;
    for (;;) {
        sum = 0u; cnt = 0u; mine = 0u;
#pragma unroll
        for (unsigned j = 0; j < 16; ++j) { const unsigned c = xb_ld(&bar[XB_XCNT(j)]); sum += c; cnt += (c > 0u) ? 1u : 0u; mine = (j == x) ? c : mine; }
        if (sum == G) break;
        __builtin_amdgcn_s_sleep(1);
        if ((++sp & 255u) == 0u) { if (xb_ld(&bar[XB_TMO])) break; if (sp > XB_SPIN_CAP) { atomicAdd(&bar[XB_TMO], 1u); break; } }
    }
    nloc = mine > 0u ? mine : 1u; nx = cnt > 0u ? cnt : 1u;
}

__device__ __forceinline__ void xcd_barrier(const XcdBarrier& b) {
    asm volatile("s_waitcnt vmcnt(0)" ::: "memory");
    __syncthreads();
    if (threadIdx.x == 0) {
        unsigned* bar = b.bar; unsigned bx = b.x; asm volatile("" : "+s"(bar), "+s"(bx));
        __builtin_amdgcn_s_waitcnt(0);
        unsigned nloc = b.st[0], nx = b.st[1];
        if (nloc == 0u) { xcd_barrier_complete(bar, bx, nloc, nx); b.st[0] = nloc; b.st[1] = nx; }
        const unsigned old = xb_add(&bar[XB_XSUB(bx)], 1u);
        const unsigned gen = old / nloc;
        if (old + 1u == (gen + 1u) * nloc) {
            __builtin_amdgcn_fence(__ATOMIC_RELEASE, "agent");
            asm volatile("s_waitcnt vmcnt(0)" ::: "memory");
            const unsigned og = xb_add(&bar[XB_TOP], 1u);
            const unsigned tg = og / nx;
            if (og + 1u == (tg + 1u) * nx) xb_add(&bar[XB_TOPGEN], 1u);
            else XB_SPIN(xb_ld(&bar[XB_TOPGEN]) == tg, bar);
            __builtin_amdgcn_fence(__ATOMIC_ACQUIRE, "agent");
            xb_add(&bar[XB_XGEN(bx)], 1u);
            asm volatile("s_waitcnt vmcnt(0)" ::: "memory");
        } else {
            XB_SPIN(xb_ld(&bar[XB_XGEN(bx)]) == gen, bar);
            __builtin_amdgcn_fence(__ATOMIC_ACQUIRE, "agent");
            asm volatile("s_waitcnt vmcnt(0)" ::: "memory");
        }
    }
    __syncthreads();
}

struct Params { const float* in[17]; float* out; unsigned char* ws; int ph_lo, ph_hi; };
enum { I_X = 0, I_C, I_WMOD, I_BMOD, I_NMIX, I_WIN, I_CONVW, I_VNORM, I_WS, I_BS, I_ONA, I_ONB, I_WOUT, I_NFFN, I_WUP, I_WDOWN, I_NFINAL };

template <int MAP> __device__ __forceinline__ int src_col(int r) {
    if (MAP == 1) { if (r < 512 || r >= 1536) return r; const int q = r - 512, j = q >> 8, h = (q >> 7) & 1, i = q & 127; return 512 + h * 512 + 128 * j + i; }
    if (MAP == 2) { const int j = r >> 8, h = (r >> 7) & 1, i = r & 127; return h * FF + 128 * j + i; }
    return r;
}
template <int MAP> __device__ __forceinline__ void transpose_item(const float* W, int K, int N, bf16* WT, LAS float* scr, int item, int lane) {
    const int nblk = N / 32, kb = item / nblk, nb = item % nblk, k0 = 64 * kb, r0 = 32 * nb, n0 = src_col<MAP>(r0);
    float tv[32];
#pragma unroll
    for (int i = 0; i < 32; ++i) tv[i] = __builtin_nontemporal_load(W + (size_t)(k0 + 2 * i + (lane >> 5)) * N + n0 + (lane & 31));
#pragma unroll
    for (int i = 0; i < 32; ++i) scr[(2 * i + (lane >> 5)) * 33 + (lane & 31)] = tv[i];
    LDS_WAIT(); asm volatile("" ::: "memory");
    const int c = lane & 7;
#pragma unroll
    for (int j = 0; j < 4; ++j) { const int n = (lane >> 3) + 8 * j; const LAS float* s = scr + (8 * c) * 33 + n;
        v4u o; o.x = pk2(s[0 * 33], s[1 * 33]); o.y = pk2(s[2 * 33], s[3 * 33]); o.z = pk2(s[4 * 33], s[5 * 33]); o.w = pk2(s[6 * 33], s[7 * 33]);
        *(v4u*)(WT + (size_t)(r0 + n) * K + k0 + 8 * c) = o; }
    LDS_WAIT(); asm volatile("" ::: "memory");
}

__device__ __forceinline__ void norm_phase(const float* X, const float* gamma, const float* modl, int sh_off, int sc_off, bf16* Hout, int gw, int NGW, int lane) {
    constexpr int NR = 2;
    f32x4 g[4];
#pragma unroll
    for (int j = 0; j < 4; ++j) g[j] = ((const f32x4*)gamma)[64 * j + lane];
    for (int m0 = gw * NR; m0 < M; m0 += NGW * NR) {
        f32x4 v[NR][4];
#pragma unroll
        for (int r = 0; r < NR; ++r)
#pragma unroll
            for (int j = 0; j < 4; ++j) v[r][j] = __builtin_nontemporal_load((const f32x4*)(X + (size_t)(m0 + r) * DM) + lane + 64 * j);
        const float* mb = modl + (size_t)(m0 >> 11) * NMOD;
        f32x4 sc[4], sh[4];
#pragma unroll
        for (int j = 0; j < 4; ++j) { sc[j] = ((const f32x4*)(mb + sc_off))[64 * j + lane] + 1.0f; sh[j] = ((const f32x4*)(mb + sh_off))[64 * j + lane]; }
#pragma unroll
        for (int r = 0; r < NR; ++r) {
            float s = 0.f;
#pragma unroll
            for (int j = 0; j < 4; ++j) s += (v[r][j].x * v[r][j].x + v[r][j].y * v[r][j].y) + (v[r][j].z * v[r][j].z + v[r][j].w * v[r][j].w);
            const float rs = 1.0f / sqrtf(wave_sum(s) * (1.f / DM) + EPS);
            unsigned long long* o8 = (unsigned long long*)(Hout + (size_t)(m0 + r) * DM) + lane;
#pragma unroll
            for (int j = 0; j < 4; ++j) { const f32x4 o = (v[r][j] * rs) * g[j] * sc[j] + sh[j];
                o8[64 * j] = (unsigned long long)pk2(o.x, o.y) | ((unsigned long long)pk2(o.z, o.w) << 32); }
        }
    }
}

__device__ __forceinline__ void norm_phase_b(const bf16* X, const float* gamma, const float* modl, int sh_off, int sc_off, bf16* Hout, int gw, int NGW, int lane) {
    constexpr int NR = 4;
    f32x4 g[2][2];
#pragma unroll
    for (int j = 0; j < 2; ++j) { g[j][0] = ((const f32x4*)gamma)[2 * (64 * j + lane)]; g[j][1] = ((const f32x4*)gamma)[2 * (64 * j + lane) + 1]; }
    for (int m0 = gw * NR; m0 < M; m0 += NGW * NR) {
        v4u w[NR][2];
#pragma unroll
        for (int r = 0; r < NR; ++r)
#pragma unroll
            for (int j = 0; j < 2; ++j) w[r][j] = ((const v4u*)(X + (size_t)(m0 + r) * DM) + lane)[64 * j];
        const float* mb = modl + (size_t)(m0 >> 11) * NMOD;
        f32x4 sc[2][2], sh[2][2];
#pragma unroll
        for (int j = 0; j < 2; ++j)
#pragma unroll
            for (int q = 0; q < 2; ++q) { sc[j][q] = ((const f32x4*)(mb + sc_off))[2 * (64 * j + lane) + q] + 1.0f; sh[j][q] = ((const f32x4*)(mb + sh_off))[2 * (64 * j + lane) + q]; }
#pragma unroll
        for (int r = 0; r < NR; ++r) {
            f32x4 v[2][2]; float s = 0.f;
#pragma unroll
            for (int j = 0; j < 2; ++j) { const v4u ww = w[r][j];
                v[j][0] = (f32x4){bflo(ww.x), bfhi(ww.x), bflo(ww.y), bfhi(ww.y)}; v[j][1] = (f32x4){bflo(ww.z), bfhi(ww.z), bflo(ww.w), bfhi(ww.w)};
#pragma unroll
                for (int q = 0; q < 2; ++q) s += (v[j][q].x * v[j][q].x + v[j][q].y * v[j][q].y) + (v[j][q].z * v[j][q].z + v[j][q].w * v[j][q].w); }
            const float rs = 1.0f / sqrtf(wave_sum(s) * (1.f / DM) + EPS);
            v4u* o16 = (v4u*)(Hout + (size_t)(m0 + r) * DM) + lane;
#pragma unroll
            for (int j = 0; j < 2; ++j) { f32x4 o[2];
#pragma unroll
                for (int q = 0; q < 2; ++q) o[q] = (v[j][q] * rs) * g[j][q] * sc[j][q] + sh[j][q];
                v4u ow; ow.x = pk2(o[0].x, o[0].y); ow.y = pk2(o[0].z, o[0].w); ow.z = pk2(o[1].x, o[1].y); ow.w = pk2(o[1].z, o[1].w);
                o16[64 * j] = ow; }
        }
    }
}

__device__ __forceinline__ void conv_phase(const bf16* PROJ, const float* convw, const float* ga, bf16* Y, int gw, int NGW, int lane) {
    float w0[8], w1[8], w2[8], gg[8];
#pragma unroll
    for (int e = 0; e < 8; ++e) { w0[e] = convw[8 * lane + e]; w1[e] = convw[512 + 8 * lane + e]; w2[e] = convw[1024 + 8 * lane + e]; gg[e] = ga[8 * lane + e]; }
    for (int run = gw; run < M / 16; run += NGW) {
        const int r0 = run * 16;
        float zm1[8], zm2[8];
        if ((r0 & (SEQ - 1)) == 0) {
#pragma unroll
            for (int e = 0; e < 8; ++e) { zm1[e] = 0.f; zm2[e] = 0.f; }
        } else {
            const v4u a = *(const v4u*)(PROJ + (size_t)(r0 - 1) * PROJW + 512 + 8 * lane), b = *(const v4u*)(PROJ + (size_t)(r0 - 2) * PROJW + 512 + 8 * lane);
            zm1[0] = bflo(a.x); zm1[1] = bfhi(a.x); zm1[2] = bflo(a.y); zm1[3] = bfhi(a.y); zm1[4] = bflo(a.z); zm1[5] = bfhi(a.z); zm1[6] = bflo(a.w); zm1[7] = bfhi(a.w);
            zm2[0] = bflo(b.x); zm2[1] = bfhi(b.x); zm2[2] = bflo(b.y); zm2[3] = bfhi(b.y); zm2[4] = bflo(b.z); zm2[5] = bfhi(b.z); zm2[6] = bflo(b.w); zm2[7] = bfhi(b.w);
        }
#pragma unroll 4
        for (int t = 0; t < 16; ++t) {
            const size_t row = (size_t)(r0 + t);
            const v4u zr = *(const v4u*)(PROJ + row * PROJW + 512 + 8 * lane), br = *(const v4u*)(PROJ + row * PROJW + 8 * lane);
            float zc[8], bg[8], ya[8];
            zc[0] = bflo(zr.x); zc[1] = bfhi(zr.x); zc[2] = bflo(zr.y); zc[3] = bfhi(zr.y); zc[4] = bflo(zr.z); zc[5] = bfhi(zr.z); zc[6] = bflo(zr.w); zc[7] = bfhi(zr.w);
            bg[0] = bflo(br.x); bg[1] = bfhi(br.x); bg[2] = bflo(br.y); bg[3] = bfhi(br.y); bg[4] = bflo(br.z); bg[5] = bfhi(br.z); bg[6] = bflo(br.w); bg[7] = bfhi(br.w);
            float s = 0.f;
#pragma unroll
            for (int e = 0; e < 8; ++e) { ya[e] = bg[e] * (w0[e] * zm2[e] + w1[e] * zm1[e] + w2[e] * zc[e]); s += ya[e] * ya[e]; zm2[e] = zm1[e]; zm1[e] = zc[e]; }
            const float rs = 1.0f / sqrtf(wave_sum(s) * (1.f / 512.f) + EPS);
            v4u o; o.x = pk2(ya[0] * rs * gg[0], ya[1] * rs * gg[1]); o.y = pk2(ya[2] * rs * gg[2], ya[3] * rs * gg[3]);
            o.z = pk2(ya[4] * rs * gg[4], ya[5] * rs * gg[5]); o.w = pk2(ya[6] * rs * gg[6], ya[7] * rs * gg[7]);
            *(v4u*)(Y + row * DM + 8 * lane) = o;
        }
    }
}

__device__ __forceinline__ void sgu_phase(LAS unsigned char* lds, const bf16* PROJp, const bf16* Wsb  , const float* vnorm, const float* bs, const float* gb, bf16* Yp,
                                          int tid, int wave, int lane) {
    const int h = wave;
    LAS bf16* VL = (LAS bf16*)(lds + h * VL_WAVE_BYTES);
    LAS float* SSQV = (LAS float*)(lds + SSQV_OFF);
    LAS float* RSV = (LAS float*)(lds + RSV_OFF);
    LAS float* SSQ2 = (LAS float*)(lds + SSQ2_OFF);
    const int r8 = lane >> 3, c8 = lane & 7, il = lane & 31, kg = lane >> 5;
    LAS float* const ssqv_w = SSQV + h * 128 + r8; LAS float* const rsv_r = RSV + r8; LAS bf16* const vl_rc = VL + r8 * VL_STRIDE + 8 * c8;
    LAS bf16* const vl_id = VL + il * VL_STRIDE + 4 * kg; LAS float* const ssq2_w = SSQ2 + h * 128 + il; LAS float* const rsw = (LAS float*)(lds + RSW_OFF) + h * 128;
    const unsigned voff_row = (unsigned)(r8 * PROJW + 8 * c8) * 2u;
    const unsigned voff_gu = (unsigned)(il * PROJW + 4 * kg) * 2u;
    const unsigned voff_w = (unsigned)(il * 128 + 8 * kg) * 2u;
    const unsigned voff_y = (unsigned)(r8 * DM + 8 * c8) * 2u;
    const char* const wbase = (const char*)(Wsb + (size_t)h * 128 * 128);
    const char* const vnb = (const char*)(vnorm + 64 * h);
    int item = blockIdx.x;
    if (item >= M / 128) return;
    for (;;) {
        const size_t t0 = (size_t)item * 128;
        v4u raw[16];
        { const char* vb = (const char*)(PROJp + t0 * PROJW + 1536 + 64 * h); unsigned vr = voff_row; asm volatile("" : "+v"(vr));
#pragma unroll
          for (int it = 0; it < 16; ++it) raw[it] = *(const v4u*)(vb + (size_t)it * (8 * PROJW * 2) + vr); }
#pragma unroll
        for (int it = 0; it < 16; ++it) {
            const v4u a = raw[it];
            float s = (bflo(a.x) * bflo(a.x) + bfhi(a.x) * bfhi(a.x)) + (bflo(a.y) * bflo(a.y) + bfhi(a.y) * bfhi(a.y)) + (bflo(a.z) * bflo(a.z) + bfhi(a.z) * bfhi(a.z)) + (bflo(a.w) * bflo(a.w) + bfhi(a.w) * bfhi(a.w));
            s += __shfl_xor(s, 1); s += __shfl_xor(s, 2); s += __shfl_xor(s, 4);
            if (c8 == 0) ssqv_w[8 * it] = s;
        }
        __syncthreads();
        if (tid < 128) { float s = 0.f;
#pragma unroll
            for (int w = 0; w < 8; ++w) s += SSQV[w * 128 + tid];
            RSV[tid] = 1.0f / sqrtf(s * (1.f / 512.f) + EPS); }
        __syncthreads();
#pragma unroll
        for (int it = 0; it < 16; ++it) {
            const float r = rsv_r[8 * it]; const v4u a = raw[it];
            v2u lo, hi; lo.x = pk2(bflo(a.x) * r, bfhi(a.x) * r); lo.y = pk2(bflo(a.y) * r, bfhi(a.y) * r); hi.x = pk2(bflo(a.z) * r, bfhi(a.z) * r); hi.y = pk2(bflo(a.w) * r, bfhi(a.w) * r);
            *(LAS v2u*)(vl_rc + it * 8 * VL_STRIDE) = lo; *(LAS v2u*)(vl_rc + it * 8 * VL_STRIDE + 4) = hi;
        }
        const int nitem = item + (int)gridDim.x; const bool has_next = nitem < M / 128;
        LDS_WAIT(); asm volatile("" ::: "memory");
        bf16x8 vf[8][2];
#pragma unroll
        for (int ks = 0; ks < 8; ++ks)
#pragma unroll
            for (int nb = 0; nb < 2; ++nb)
#pragma unroll
                for (int e = 0; e < 8; ++e) vf[ks][nb][e] = (short)VL[(16 * ks + 8 * kg + e) * VL_STRIDE + 32 * nb + il];
        LDS_WAIT(); asm volatile("" ::: "memory");
#pragma unroll
        for (int mb = 0; mb < 4; ++mb) {
            const int i = 32 * mb + il;
            const char* gub = (const char*)(PROJp + (t0 + 32 * mb) * PROJW + 1024 + 64 * h); unsigned vg = voff_gu, vw = voff_w, vv = (unsigned)(16 * kg); asm volatile("" : "+v"(vg), "+v"(vw), "+v"(vv));
            v2u gu[2][4];
#pragma unroll
            for (int nb = 0; nb < 2; ++nb)
#pragma unroll
                for (int blk = 0; blk < 4; ++blk) gu[nb][blk] = *(const v2u*)(gub + vg + (32 * nb + 8 * blk) * 2);
            f32x16 acc[2];
#pragma unroll
            for (int nb = 0; nb < 2; ++nb)
#pragma unroll
                for (int r = 0; r < 16; ++r) acc[nb][r] = 0.f;
            const char* wb = wbase + (size_t)(32 * mb) * 128 * 2;
#pragma unroll
            for (int ks = 0; ks < 2 * (mb + 1); ++ks) {
                const bf16x8 wf = *(const bf16x8*)(wb + vw + ks * 32);
                acc[0] = __builtin_amdgcn_mfma_f32_32x32x16_bf16(vf[ks][0], wf, acc[0], 0, 0, 0);
                acc[1] = __builtin_amdgcn_mfma_f32_32x32x16_bf16(vf[ks][1], wf, acc[1], 0, 0, 0);
            }
            const float bsv = bs[h * 128 + i];
            float ss = 0.f;
#pragma unroll
            for (int nb = 0; nb < 2; ++nb)
#pragma unroll
                for (int blk = 0; blk < 4; ++blk) {
                    const f32x4 vn = *(const f32x4*)(vnb + vv + (32 * nb + 8 * blk) * 4);
                    const float y0 = bflo(gu[nb][blk].x) * (acc[nb][4 * blk + 0] * vn.x + bsv), y1 = bfhi(gu[nb][blk].x) * (acc[nb][4 * blk + 1] * vn.y + bsv);
                    const float y2 = bflo(gu[nb][blk].y) * (acc[nb][4 * blk + 2] * vn.z + bsv), y3 = bfhi(gu[nb][blk].y) * (acc[nb][4 * blk + 3] * vn.w + bsv);
                    ss += (y0 * y0 + y1 * y1) + (y2 * y2 + y3 * y3);
                    v2u o; o.x = pk2(y0, y1); o.y = pk2(y2, y3);
                    *(LAS v2u*)(vl_id + 32 * mb * VL_STRIDE + 32 * nb + 8 * blk) = o;
                }
            ss += __shfl_xor(ss, 32);
            if (kg == 0) ssq2_w[32 * mb] = ss;
            asm volatile("" ::: "memory");
        }
        __syncthreads();
        const f32x4 g0 = *(const f32x4*)(gb + 64 * h + 8 * c8), g1 = *(const f32x4*)(gb + 64 * h + 8 * c8 + 4);
        float ta = 0.f, tb = 0.f;
#pragma unroll
        for (int w = 0; w < 8; ++w) { ta += SSQ2[w * 128 + lane]; tb += SSQ2[w * 128 + 64 + lane]; }
        rsw[lane] = 1.0f / sqrtf(ta * (1.f / 512.f) + EPS); rsw[64 + lane] = 1.0f / sqrtf(tb * (1.f / 512.f) + EPS);
        LDS_WAIT(); asm volatile("" ::: "memory");
        char* const yb = (char*)(Yp + t0 * DM + 512 + 64 * h); unsigned vy = voff_y; asm volatile("" : "+v"(vy));
#pragma unroll
        for (int it = 0; it < 16; ++it) {
            const float rs = (rsw + r8)[8 * it];
            const v2u lo = *(const LAS v2u*)(vl_rc + it * 8 * VL_STRIDE), hi = *(const LAS v2u*)(vl_rc + it * 8 * VL_STRIDE + 4);
            v4u o; o.x = pk2(bflo(lo.x) * rs * g0.x, bfhi(lo.x) * rs * g0.y); o.y = pk2(bflo(lo.y) * rs * g0.z, bfhi(lo.y) * rs * g0.w);
            o.z = pk2(bflo(hi.x) * rs * g1.x, bfhi(hi.x) * rs * g1.y); o.w = pk2(bflo(hi.y) * rs * g1.z, bfhi(hi.y) * rs * g1.w);
            *(v4u*)(yb + (size_t)it * (8 * DM * 2) + vy) = o;
            if ((it & 3) == 3) asm volatile("" ::: "memory");
        }
        if (!has_next) break;
        item = nitem;
    }
}

constexpr int NPHASE = 16;
__global__ void __launch_bounds__(NTHR, 2) fwd_megakernel(Params p) {
    extern __shared__ __attribute__((aligned(16))) unsigned char lds_raw[];
    LAS unsigned char* lds = (LAS unsigned char*)lds_raw;
    cg::grid_group grid = cg::this_grid();
    const int G = gridDim.x, NGW = G * NWAVES;
#define LANE_IDS() int tid_l = threadIdx.x; asm volatile("" : "+v"(tid_l)); const int tid = tid_l, lane = tid & 63, wave = __builtin_amdgcn_readfirstlane(tid >> 6), gw = blockIdx.x * NWAVES + wave; (void)lane; (void)gw; (void)tid; KARG_BASE()
    typedef const __attribute__((address_space(4))) unsigned long long* kargp_t;
#define KARG_BASE() kargp_t ka_ = (kargp_t)__builtin_amdgcn_kernarg_segment_ptr(); asm volatile("" : "+s"(ka_)); unsigned char* const ws = (unsigned char*)ka_[18]; (void)ws
#define PIN(i) ((const float*)ka_[i])
#define POUT ((float*)ka_[17])
#define MOD ((float*)(ws + WS_MOD))
#define H ((bf16*)(ws + WS_H))
#define PROJ ((bf16*)(ws + WS_PROJ))
#define Y ((bf16*)(ws + WS_Y))
#define ACT ((bf16*)(ws + WS_ACT))
#define X1 ((bf16*)(ws + WS_X1))
#ifdef DIAG_ONLY
#define IN(k) (((k) == DIAG_ONLY))
#else
#define IN(k) (true)
#endif
    if (threadIdx.x < 16) ((LAS unsigned*)(lds + MISC_OFF))[threadIdx.x] = 0u;
    __syncthreads();
    XcdBarrier bar; { KARG_BASE(); bar = xcd_barrier_post((unsigned*)(ws + WS_CTL), (volatile LAS unsigned*)(lds + MISC_OFF)); }
#ifndef PROBE_MASK
#define PROBE_MASK 0
#endif
#define REPS(k) for (int rep_ = 0; rep_ <= ((PROBE_MASK >> (k)) & 1); ++rep_)
#define REP_BAR() do { if (rep_) xcd_barrier(bar); } while (0)
#define SEAM(k) do { if (IN(k) && IN((k) + 1)) xcd_barrier(bar); } while (0)
    grid.sync();

    if (IN(0)) REPS(0) {
        REP_BAR();
        LANE_IDS();
        LAS float* scr = (LAS float*)(lds + wave * 16384);
        constexpr int I_IN = 16 * (NIN / 32), I_OUT = 16 * (DM / 32), I_UP = 16 * (NUP / 32), I_DN = (FF / 64) * (DM / 32), I_L = I_IN + I_OUT + I_UP + I_DN;
        for (int it = gw; it < DEPTH * I_L; it += NGW) {
            const int l = it / I_L; int r = it % I_L;
            if (r < I_IN) { transpose_item<1>(PIN(I_WIN) + (size_t)l * DM * NIN, DM, NIN, (bf16*)(ws + WS_WIN) + (size_t)l * NIN * DM, scr, r, lane); continue; } r -= I_IN;
            if (r < I_OUT) { transpose_item<0>(PIN(I_WOUT) + (size_t)l * DM * DM, DM, DM, (bf16*)(ws + WS_WOUT) + (size_t)l * DM * DM, scr, r, lane); continue; } r -= I_OUT;
            if (r < I_UP) { transpose_item<2>(PIN(I_WUP) + (size_t)l * DM * NUP, DM, NUP, (bf16*)(ws + WS_WUP) + (size_t)l * NUP * DM, scr, r, lane); continue; } r -= I_UP;
            transpose_item<0>(PIN(I_WDOWN) + (size_t)l * FF * DM, FF, DM, (bf16*)(ws + WS_WDN) + (size_t)l * DM * FF, scr, r, lane);
        }
        { bf16* Wsb = (bf16*)(ws + WS_WSB); const float* wsrc = PIN(I_WS);
          for (int e = blockIdx.x * NTHR + tid; e < DEPTH * 8 * 128 * 128; e += G * NTHR) { const int j = e & 127, i = (e >> 7) & 127; Wsb[e] = (bf16)(j <= i ? f2bf(wsrc[e]) : 0u); } }
        __syncthreads();
        for (int item = blockIdx.x; item < DEPTH * (NMOD / 64); item += G) {
            const int l = item / (NMOD / 64), col0 = (item % (NMOD / 64)) * 64;
            LAS float* cact = (LAS float*)lds;
            LAS float* red = (LAS float*)(lds + 65536);
            for (int idx = tid; idx < BATCH * DM; idx += NTHR) { const int b = idx >> 10, k = idx & 1023; const float cv = PIN(I_C)[idx]; cact[k * 16 + b] = cv / (1.0f + expf(-cv)); }
            __syncthreads();
            float a[16];
#pragma unroll
            for (int b = 0; b < 16; ++b) a[b] = 0.f;
            const float* wp = PIN(I_WMOD) + (size_t)l * DM * NMOD + (size_t)(wave * 128) * NMOD + col0 + lane;
            for (int k0 = 0; k0 < 128; k0 += 32) {
            float wv32[32];
#pragma unroll
            for (int kk = 0; kk < 32; ++kk) wv32[kk] = __builtin_nontemporal_load(wp + (size_t)(k0 + kk) * NMOD);
#pragma unroll
            for (int kk = 0; kk < 32; ++kk) { const int k = k0 + kk;
                const float wv = wv32[kk];
                const LAS f32x4* cr = (const LAS f32x4*)(cact + (wave * 128 + k) * 16);
                const f32x4 c0 = cr[0], c1 = cr[1], c2 = cr[2], c3 = cr[3];
                a[0] += c0.x * wv; a[1] += c0.y * wv; a[2] += c0.z * wv; a[3] += c0.w * wv; a[4] += c1.x * wv; a[5] += c1.y * wv; a[6] += c1.z * wv; a[7] += c1.w * wv;
                a[8] += c2.x * wv; a[9] += c2.y * wv; a[10] += c2.z * wv; a[11] += c2.w * wv; a[12] += c3.x * wv; a[13] += c3.y * wv; a[14] += c3.z * wv; a[15] += c3.w * wv;
            }
            }
#pragma unroll
            for (int b = 0; b < 16; ++b) red[(wave * 16 + b) * 64 + lane] = a[b];
            __syncthreads();
            for (int o = tid; o < 16 * 64; o += NTHR) { const int b = o >> 6, cc = o & 63; float s = PIN(I_BMOD)[l * NMOD + col0 + cc];
#pragma unroll
                for (int w = 0; w < 8; ++w) s += red[(w * 16 + b) * 64 + cc];
                MOD[((size_t)l * BATCH + b) * NMOD + col0 + cc] = s; }
            __syncthreads();
        }
    }
    SEAM(0);

#ifndef PROBE_LAYER
#define PROBE_LAYER 0
#endif
    for (int li = 0; li < DEPTH + PROBE_LAYER; ++li) {
        const int l = (li <= PROBE_LAYER) ? 0 : li - PROBE_LAYER;
        const int P = 1 + 7 * l;
#define modl (MOD + (size_t)l * BATCH * NMOD)
        if (IN(P + 0)) REPS(P + 0) { REP_BAR(); LANE_IDS(); if (l == 0) norm_phase(PIN(I_X), PIN(I_NMIX) + l * DM, modl, 0 * DM, 1 * DM, H, gw, NGW, lane); else norm_phase_b(X1, PIN(I_NMIX) + l * DM, modl, 0 * DM, 1 * DM, H, gw, NGW, lane); }
        SEAM(P + 0);
        if (IN(P + 1)) REPS(P + 1) {
            REP_BAR();
            KARG_BASE();
            pg8::Gemm g{H, (const bf16*)(ws + WS_WIN) + (size_t)l * NIN * DM, M, NIN, DM}; pg8::StaticOrder S; S.init(M, NIN, G, (int)blockIdx.x);
            pg8::EpiProj E{PROJ};
            pg8::gemm_phase<pg8::EpiProj, pg8::StaticOrder, true, true>(lds, g, S, E);
        }
        SEAM(P + 1);
        if (IN(P + 2)) REPS(P + 2) {
            REP_BAR();
            LANE_IDS();
            sgu_phase(lds, PROJ, (const bf16*)(ws + WS_WSB) + (size_t)l * 8 * 128 * 128, PIN(I_VNORM) + l * 512, PIN(I_BS) + l * 8 * 128, PIN(I_ONB) + l * 512, Y, tid, wave, lane);
            conv_phase(PROJ, PIN(I_CONVW) + l * 3 * 512, PIN(I_ONA) + l * 512, Y, gw, NGW, lane);
        }
        SEAM(P + 2);
        if (IN(P + 3)) REPS(P + 3) {
            REP_BAR();
            KARG_BASE();
            pg8::Gemm g{Y, (const bf16*)(ws + WS_WOUT) + (size_t)l * DM * DM, M, DM, DM}; pg8::StaticOrder S; S.init(M, DM, G, (int)blockIdx.x);
            if (l == 0) { pg8::EpiResB<true> E{PIN(I_X), X1, modl + 2 * DM, NMOD}; pg8::gemm_phase<pg8::EpiResB<true>, pg8::StaticOrder, true, true>(lds, g, S, E); }
            else { pg8::EpiResB<false> E{X1, X1, modl + 2 * DM, NMOD}; pg8::gemm_phase<pg8::EpiResB<false>, pg8::StaticOrder, true, true>(lds, g, S, E); }
        }
        SEAM(P + 3);
        if (IN(P + 4)) REPS(P + 4) { REP_BAR(); LANE_IDS(); norm_phase_b(X1, PIN(I_NFFN) + l * DM, modl, 3 * DM, 4 * DM, H, gw, NGW, lane); }
        SEAM(P + 4);
        if (IN(P + 5)) REPS(P + 5) {
            REP_BAR();
            KARG_BASE();
            pg8::Gemm g{H, (const bf16*)(ws + WS_WUP) + (size_t)l * NUP * DM, M, NUP, DM}; pg8::StaticOrder S; S.init(M, NUP, G, (int)blockIdx.x);
            pg8::EpiSwiGLU E{ACT, FF};
            pg8::gemm_phase<pg8::EpiSwiGLU, pg8::StaticOrder, true, true>(lds, g, S, E);
        }
        SEAM(P + 5);
        if (IN(P + 6)) REPS(P + 6) {
            REP_BAR();
            KARG_BASE();
            pg8::Gemm g{ACT, (const bf16*)(ws + WS_WDN) + (size_t)l * DM * FF, M, DM, FF}; pg8::StaticOrder S; S.init(M, DM, G, (int)blockIdx.x);
            pg8::EpiResB<false> E{X1, X1, modl + 5 * DM, NMOD};
            pg8::gemm_phase<pg8::EpiResB<false>, pg8::StaticOrder, true, true>(lds, g, S, E);
        }
        SEAM(P + 6);
    }
    if (IN(15)) {
        LANE_IDS();
        constexpr int NR = 4;
        f32x4 g[2][2];
#pragma unroll
        for (int j = 0; j < 2; ++j) { g[j][0] = ((const f32x4*)PIN(I_NFINAL))[2 * (64 * j + lane)]; g[j][1] = ((const f32x4*)PIN(I_NFINAL))[2 * (64 * j + lane) + 1]; }
        for (int m0 = gw * NR; m0 < M; m0 += NGW * NR) {
            v4u w[NR][2];
#pragma unroll
            for (int r = 0; r < NR; ++r)
#pragma unroll
                for (int j = 0; j < 2; ++j) w[r][j] = ((const v4u*)(X1 + (size_t)(m0 + r) * DM) + lane)[64 * j];
#pragma unroll
            for (int r = 0; r < NR; ++r) {
                f32x4 v[2][2]; float s = 0.f;
#pragma unroll
                for (int j = 0; j < 2; ++j) { const v4u ww = w[r][j];
                    v[j][0] = (f32x4){bflo(ww.x), bfhi(ww.x), bflo(ww.y), bfhi(ww.y)}; v[j][1] = (f32x4){bflo(ww.z), bfhi(ww.z), bflo(ww.w), bfhi(ww.w)};
#pragma unroll
                    for (int q = 0; q < 2; ++q) s += (v[j][q].x * v[j][q].x + v[j][q].y * v[j][q].y) + (v[j][q].z * v[j][q].z + v[j][q].w * v[j][q].w); }
                const float rs = 1.0f / sqrtf(wave_sum(s) * (1.f / DM) + EPS);
                f32x4* orow = (f32x4*)(POUT + (size_t)(m0 + r) * DM);
#pragma unroll
                for (int j = 0; j < 2; ++j)
#pragma unroll
                    for (int q = 0; q < 2; ++q) __builtin_nontemporal_store((v[j][q] * rs) * g[j][q], orow + 2 * (64 * j + lane) + q);
            }
        }
    }
#undef IN
#undef SEAM
}

#undef MOD
#undef H
#undef PROJ
#undef Y
#undef ACT
#undef X1
#undef modl
#undef xin
extern "C" void kernel_launch(void* const* d_in, const int* in_sizes, int n_in, void* d_out, int out_size, void* d_ws, size_t ws_size, hipStream_t stream) {
    static int grid = 0;
    if (grid == 0) {
        if (n_in != 17 || in_sizes[0] != M * DM || out_size != M * DM || ws_size < WS_END) { fprintf(stderr, "kernel_launch: unexpected shapes (n_in %d, in0 %d, out %d, ws %zu); nothing launched\n", n_in, n_in > 0 ? in_sizes[0] : -1, out_size, ws_size); grid = -1; return; }
        int dev = 0, cus = 0, per_cu = 0;
        hipGetDevice(&dev); hipDeviceGetAttribute(&cus, hipDeviceAttributeMultiprocessorCount, dev);
        if (hipFuncSetAttribute((const void*)fwd_megakernel, hipFuncAttributeMaxDynamicSharedMemorySize, LDS_BYTES) != hipSuccess) { fprintf(stderr, "kernel_launch: hipFuncSetAttribute failed\n"); grid = -1; return; }
        if (hipOccupancyMaxActiveBlocksPerMultiprocessor(&per_cu, (const void*)fwd_megakernel, NTHR, LDS_BYTES) != hipSuccess || per_cu < 1) { fprintf(stderr, "kernel_launch: occupancy query says %d blocks per CU; nothing launched\n", per_cu); (void)hipGetLastError(); grid = -1; return; }
        grid = cus * (per_cu > 1 ? 1 : per_cu);
    }
    if (grid < 0) return;
    if (hipMemsetAsync((char*)d_ws + WS_CTL, 0, CTL_BYTES, stream) != hipSuccess) { fprintf(stderr, "kernel_launch: hipMemsetAsync failed\n"); return; }
    Params p{};
    for (int i = 0; i < 17; ++i) p.in[i] = (const float*)d_in[i];
    p.out = (float*)d_out; p.ws = (unsigned char*)d_ws;
    p.ph_lo = 0; p.ph_hi = NPHASE;
    void* args[] = {&p};
    hipError_t e = hipLaunchCooperativeKernel((const void*)fwd_megakernel, dim3(grid), dim3(NTHR), args, LDS_BYTES, stream);
    if (e != hipSuccess) fprintf(stderr, "cooperative launch failed: %s (grid %d)\n", hipGetErrorString(e), grid);
}
```

```cpp
#include <hip/hip_runtime.h>
#include <hip/hip_cooperative_groups.h>
#include <cstdio>
#include <cstdint>
namespace cg = cooperative_groups;
#define MK_PER_PHASE 0
#define PROBE_MASK 0
#define PROBE_LAYER 0
namespace pg8 {
#define PG8_LAS __attribute__((address_space(3)))
typedef unsigned short bf16_t;
typedef short bf16x8 __attribute__((ext_vector_type(8)));
typedef float f32x4 __attribute__((ext_vector_type(4)));
typedef unsigned u32x4 __attribute__((ext_vector_type(4)));
constexpr int BM = 256, BK = 64, HALF = 128, HTB = HALF * BK * 2  , STAGE_BYTES = 8 * HTB, NXCD = 8, WGM = 4;

__host__ __device__ __forceinline__ int lds_byte(int r, int c) { const int st = (r >> 4) * 2 + (c >> 5), rr = r & 15, cc = c & 31, ob = rr * 64 + cc * 2; return st * 1024 + (ob ^ (((ob >> 9) & 1) << 5)); }
__host__ __device__ __forceinline__ void stage_rc(int b, int& R, int& C) { const int st = b / 1024, sb = b % 1024, swz = sb ^ (((sb >> 9) & 1) << 5); R = (st >> 1) * 16 + swz / 64; C = (st & 1) * 32 + (swz % 64) / 2; }
__host__ __device__ __forceinline__ int perm32(int rho) { const int n = rho >> 4, i = rho & 15; return 8 * (i >> 2) + 4 * n + (i & 3); }

struct Unit { int pm, pn; };
struct Gemm { const bf16_t* A; const bf16_t* Bt; int M, N, K; };

struct StaticOrder {
    int nM, nN, nwg, G, c;
    __host__ __device__ void init(int M, int N, int G_, int c_) { nM = M / BM; nN = N / BM; nwg = nM * nN; G = G_; c = c_; }
    __host__ __device__ bool next(int i, Unit& u) const {
        const long L = (long)i * G + c; if (L >= nwg) return false;
        int wgid = (int)L; { const int q = nwg / NXCD, r = nwg % NXCD, xcd = wgid % NXCD, off = wgid / NXCD; wgid = (xcd < r ? xcd * (q + 1) : r * (q + 1) + (xcd - r) * q) + off; }
        const int nig = WGM * nN, gid = wgid / nig, fm = gid * WGM, gsz = (nM - fm) < WGM ? (nM - fm) : WGM;
        u.pm = fm + ((wgid % nig) % gsz); u.pn = (wgid % nig) / gsz; return true;
    }
    __device__ __forceinline__ void a_ready(const Unit&) const {}
    __device__ __forceinline__ void done(const Unit&) const {}
};


__device__ __forceinline__ unsigned cvt_pk_bf16(float lo, float hi) { unsigned r; asm volatile("v_cvt_pk_bf16_f32 %0, %1, %2" : "=v"(r) : "v"(lo), "v"(hi)); return r; }
__device__ __forceinline__ float gelu_t(float x) {
    const float u2 = x * (1.5957691216f + 0.0713548163f * x * x);
    const float e = __builtin_amdgcn_exp2f(-1.4426950409f * u2);
    return x * __builtin_amdgcn_rcpf(1.0f + e);
}
__device__ __forceinline__ float silu_f(float x) {
    const float e = __builtin_amdgcn_exp2f(-1.4426950409f * x);
    return x * __builtin_amdgcn_rcpf(1.0f + e);
}
struct EpiProj {
    static constexpr bool PERM = true, AFTER_DRAIN = false;
    bf16_t* O;
    __device__ __forceinline__ void operator()(const f32x4 (&acc)[2][2][4][2], const Unit& u, int wr, int wc, int fr, int fq) const {
        const int row0 = u.pm * BM + wr * 64 + fr; const int pn = u.pn;
        if (pn < 2) {
            const int col0 = 256 * pn + wc * 32 + 8 * fq;
#pragma unroll
            for (int ai = 0; ai < 2; ++ai)
#pragma unroll
                for (int m = 0; m < 4; ++m) { bf16_t* rowp = O + (size_t)(row0 + ai * HALF + m * 16) * 2048 + col0;
#pragma unroll
                    for (int bj = 0; bj < 2; ++bj) { const f32x4 v0 = acc[ai][bj][m][0], v1 = acc[ai][bj][m][1];
                        u32x4 w; w.x = cvt_pk_bf16(v0[0], v0[1]); w.y = cvt_pk_bf16(v0[2], v0[3]); w.z = cvt_pk_bf16(v1[0], v1[1]); w.w = cvt_pk_bf16(v1[2], v1[3]);
                        *(u32x4*)(rowp + bj * HALF) = w; } }
        } else if (pn < 6) {
            const int col0 = 512 + 128 * (pn - 2) + wc * 32 + 8 * fq;
#pragma unroll
            for (int ai = 0; ai < 2; ++ai)
#pragma unroll
                for (int m = 0; m < 4; ++m) { bf16_t* rowp = O + (size_t)(row0 + ai * HALF + m * 16) * 2048 + col0;
                    const f32x4 v0 = acc[ai][0][m][0] * acc[ai][1][m][0], v1 = acc[ai][0][m][1] * acc[ai][1][m][1];
                    u32x4 w; w.x = cvt_pk_bf16(v0[0], v0[1]); w.y = cvt_pk_bf16(v0[2], v0[3]); w.z = cvt_pk_bf16(v1[0], v1[1]); w.w = cvt_pk_bf16(v1[2], v1[3]);
                    *(u32x4*)(rowp) = w; }
        } else {
            const int col0 = 1024 + 256 * (pn - 6) + wc * 32 + 8 * fq;
#pragma unroll
            for (int ai = 0; ai < 2; ++ai)
#pragma unroll
                for (int m = 0; m < 4; ++m) { bf16_t* rowp = O + (size_t)(row0 + ai * HALF + m * 16) * 2048 + col0;
#pragma unroll
                    for (int bj = 0; bj < 2; ++bj) { const f32x4 v0 = acc[ai][bj][m][0], v1 = acc[ai][bj][m][1];
                        u32x4 w; w.x = cvt_pk_bf16(gelu_t(v0[0]), gelu_t(v0[1])); w.y = cvt_pk_bf16(gelu_t(v0[2]), gelu_t(v0[3]));
                        w.z = cvt_pk_bf16(gelu_t(v1[0]), gelu_t(v1[1])); w.w = cvt_pk_bf16(gelu_t(v1[2]), gelu_t(v1[3]));
                        *(u32x4*)(rowp + bj * HALF) = w; } }
        }
    }
};
struct EpiSwiGLU {
    static constexpr bool PERM = true, AFTER_DRAIN = false;
    bf16_t* O; int ldc;
    __device__ __forceinline__ void operator()(const f32x4 (&acc)[2][2][4][2], const Unit& u, int wr, int wc, int fr, int fq) const {
        const int row0 = u.pm * BM + wr * 64 + fr; const int col0 = 128 * u.pn + wc * 32 + 8 * fq;
#pragma unroll
        for (int ai = 0; ai < 2; ++ai)
#pragma unroll
            for (int m = 0; m < 4; ++m) { bf16_t* rowp = O + (size_t)(row0 + ai * HALF + m * 16) * ldc + col0;
                const f32x4 g0 = acc[ai][0][m][0], g1 = acc[ai][0][m][1], u0 = acc[ai][1][m][0], u1 = acc[ai][1][m][1];
                u32x4 w; w.x = cvt_pk_bf16(silu_f(g0[0]) * u0[0], silu_f(g0[1]) * u0[1]); w.y = cvt_pk_bf16(silu_f(g0[2]) * u0[2], silu_f(g0[3]) * u0[3]);
                w.z = cvt_pk_bf16(silu_f(g1[0]) * u1[0], silu_f(g1[1]) * u1[1]); w.w = cvt_pk_bf16(silu_f(g1[2]) * u1[2], silu_f(g1[3]) * u1[3]);
                *(u32x4*)(rowp) = w; }
    }
};
struct EpiRes {
    static constexpr bool PERM = false, AFTER_DRAIN = false;
    const float* base; float* out; const float* gate; int gstride;
    __device__ __forceinline__ void operator()(const f32x4 (&acc)[2][2][4][2], const Unit& u, int wr, int wc, int fr, int fq) const {
        const int row0 = u.pm * BM + wr * 64 + fr, col0 = u.pn * BM + wc * 32 + 4 * fq;
        const float* gp = gate + (size_t)(u.pm >> 3) * gstride + col0;
        f32x4 gv[2][2];
#pragma unroll
        for (int bj = 0; bj < 2; ++bj)
#pragma unroll
            for (int n = 0; n < 2; ++n) gv[bj][n] = *(const f32x4*)(gp + bj * HALF + n * 16);
#pragma unroll
        for (int ai = 0; ai < 2; ++ai)
#pragma unroll
            for (int m = 0; m < 4; ++m) { const size_t off = (size_t)(row0 + ai * HALF + m * 16) * 1024 + col0;
#pragma unroll
                for (int bj = 0; bj < 2; ++bj)
#pragma unroll
                    for (int n = 0; n < 2; ++n) { const f32x4 bs = *(const f32x4*)(base + off + bj * HALF + n * 16);
                        *(f32x4*)(out + off + bj * HALF + n * 16) = bs + gv[bj][n] * acc[ai][bj][m][n]; }
                asm volatile("" ::: "memory"); }
    }
};

template <bool BASE_F32> struct EpiResB {
    static constexpr bool PERM = true, AFTER_DRAIN = false;
    const void* base; bf16_t* out; const float* gate; int gstride;
    static __device__ __forceinline__ void unpack(const u32x4 ww, f32x4& lo, f32x4& hi) {
        lo = (f32x4){__builtin_bit_cast(float, ww.x << 16), __builtin_bit_cast(float, ww.x & 0xffff0000u), __builtin_bit_cast(float, ww.y << 16), __builtin_bit_cast(float, ww.y & 0xffff0000u)};
        hi = (f32x4){__builtin_bit_cast(float, ww.z << 16), __builtin_bit_cast(float, ww.z & 0xffff0000u), __builtin_bit_cast(float, ww.w << 16), __builtin_bit_cast(float, ww.w & 0xffff0000u)};
    }
    __device__ __forceinline__ void operator()(const f32x4 (&acc)[2][2][4][2], const Unit& u, int wr, int wc, int fr, int fq) const {
        const int row0 = u.pm * BM + wr * 64 + fr, col0 = u.pn * BM + wc * 32 + 8 * fq;
        bf16_t* op = out + (size_t)row0 * 1024 + col0;
        if (!BASE_F32) {
            const bf16_t* bp = (const bf16_t*)base + (size_t)row0 * 1024 + col0;
            u32x4 w[2][4][2];
#pragma unroll
            for (int ai = 0; ai < 2; ++ai)
#pragma unroll
                for (int m = 0; m < 4; ++m)
#pragma unroll
                    for (int bj = 0; bj < 2; ++bj) w[ai][m][bj] = *(const u32x4*)(bp + (size_t)(ai * HALF + m * 16) * 1024 + bj * HALF);
            const float* gp = gate + (size_t)(u.pm >> 3) * gstride + col0;
            f32x4 gv[2][2];
#pragma unroll
            for (int bj = 0; bj < 2; ++bj)
#pragma unroll
                for (int n = 0; n < 2; ++n) gv[bj][n] = *(const f32x4*)(gp + bj * HALF + 4 * n);
            asm volatile("" ::: "memory");
#pragma unroll
            for (int ai = 0; ai < 2; ++ai)
#pragma unroll
                for (int m = 0; m < 4; ++m)
#pragma unroll
                    for (int bj = 0; bj < 2; ++bj) {
                        f32x4 lo, hi; unpack(w[ai][m][bj], lo, hi);
                        const f32x4 v0 = lo + gv[bj][0] * acc[ai][bj][m][0], v1 = hi + gv[bj][1] * acc[ai][bj][m][1];
                        u32x4 o; o.x = cvt_pk_bf16(v0[0], v0[1]); o.y = cvt_pk_bf16(v0[2], v0[3]); o.z = cvt_pk_bf16(v1[0], v1[1]); o.w = cvt_pk_bf16(v1[2], v1[3]);
                        *(u32x4*)(op + (size_t)(ai * HALF + m * 16) * 1024 + bj * HALF) = o; }
        } else {
            const float* gp = gate + (size_t)(u.pm >> 3) * gstride + col0;
            f32x4 gv[2][2];
#pragma unroll
            for (int bj = 0; bj < 2; ++bj)
#pragma unroll
                for (int n = 0; n < 2; ++n) gv[bj][n] = *(const f32x4*)(gp + bj * HALF + 4 * n);
#pragma unroll
            for (int ai = 0; ai < 2; ++ai) {
                f32x4 b0[4][2], b1[4][2];
#pragma unroll
                for (int m = 0; m < 4; ++m)
#pragma unroll
                    for (int bj = 0; bj < 2; ++bj) { const float* bp = (const float*)base + (size_t)(row0 + ai * HALF + m * 16) * 1024 + col0 + bj * HALF;
                        b0[m][bj] = __builtin_nontemporal_load((const f32x4*)bp); b1[m][bj] = __builtin_nontemporal_load((const f32x4*)(bp + 4)); }
#pragma unroll
                for (int m = 0; m < 4; ++m)
#pragma unroll
                    for (int bj = 0; bj < 2; ++bj) {
                        const f32x4 v0 = b0[m][bj] + gv[bj][0] * acc[ai][bj][m][0], v1 = b1[m][bj] + gv[bj][1] * acc[ai][bj][m][1];
                        u32x4 o; o.x = cvt_pk_bf16(v0[0], v0[1]); o.y = cvt_pk_bf16(v0[2], v0[3]); o.z = cvt_pk_bf16(v1[0], v1[1]); o.w = cvt_pk_bf16(v1[2], v1[3]);
                        *(u32x4*)(op + (size_t)(ai * HALF + m * 16) * 1024 + bj * HALF) = o; }
                asm volatile("" ::: "memory");
            }
        }
    }
};


template <class Epi, class Sched, bool ALIGN_EPI = false, bool SP2 = false>
__device__ __forceinline__ void gemm_phase(PG8_LAS unsigned char* lds, const Gemm g, const Sched& S, const Epi& E) {
    int tid_l = threadIdx.x; asm volatile("" : "+v"(tid_l));
    const int tid = tid_l, wid = __builtin_amdgcn_readfirstlane(tid >> 6), lane = tid & 63, wr = wid >> 2, wc = wid & 3, fr = lane & 15, fq = lane >> 4;
    const int K = g.K, nt = K / BK;
    unsigned voffA[2], voffB[2];
#pragma unroll
    for (int i = 0; i < 2; ++i) { int R, C; stage_rc(tid * 16 + i * 8192, R, C); const int Rb = Epi::PERM ? ((R & ~31) + perm32(R & 31)) : R;
        voffA[i] = (unsigned)(R * K + C) * 2u; voffB[i] = (unsigned)(Rb * K + C) * 2u; }
    const size_t kstep = (size_t)(BK * 2);
    const size_t hstep = (size_t)HALF * K * 2;
    const size_t tstep = 2 * hstep;
    const unsigned ldsw = (unsigned)wid * 1024u;
    const int aoff = lds_byte(wr * 64 + fr, fq * 8), boff = lds_byte(wc * 32 + fr, fq * 8);
#define PG8_SA(b, h) (((b) * 2 + (h)) * HTB)
#define PG8_SB(b, h) ((4 + (b) * 2 + (h)) * HTB)
#define PG8_STAGE(bufoff, gbase, voff) do { _Pragma("unroll") for (int _i = 0; _i < 2; ++_i) \
        __builtin_amdgcn_global_load_lds((const unsigned*)((const char*)(gbase) + (voff)[_i]), (PG8_LAS unsigned*)(lds + (bufoff) + ldsw + _i * 8192), 16, 0, 0); } while (0)
#define PG8_LDA(dst, b, h) do { _Pragma("unroll") for (int m = 0; m < 4; ++m) _Pragma("unroll") for (int k = 0; k < 2; ++k) dst[m][k] = *(const PG8_LAS bf16x8*)(lds + PG8_SA(b, h) + aoff + m * 2048 + k * 1024); } while (0)
#define PG8_LDB(dst, b, h) do { _Pragma("unroll") for (int n = 0; n < 2; ++n) _Pragma("unroll") for (int k = 0; k < 2; ++k) dst[n][k] = *(const PG8_LAS bf16x8*)(lds + PG8_SB(b, h) + boff + n * 2048 + k * 1024); } while (0)
#define PG8_MMA(ai, bj, At, Bt) do { __builtin_amdgcn_s_setprio(1); _Pragma("unroll") for (int m = 0; m < 4; ++m) _Pragma("unroll") for (int n = 0; n < 2; ++n) _Pragma("unroll") for (int k = 0; k < 2; ++k) \
        acc[ai][bj][m][n] = __builtin_amdgcn_mfma_f32_16x16x32_bf16(Bt[n][k], At[m][k], acc[ai][bj][m][n], 0, 0, 0); __builtin_amdgcn_s_setprio(0); } while (0)
#define PG8_WAIT_V(n) asm volatile("s_waitcnt vmcnt(" #n ")" ::: "memory")
#define PG8_WAIT_L(n) asm volatile("s_waitcnt lgkmcnt(" #n ")" ::: "memory")
#define PG8_BAR __builtin_amdgcn_s_barrier()
#define PG8_SCHED __builtin_amdgcn_sched_barrier(0)
    Unit cur, nxt; int ui = 0;
    if (!S.next(0, cur)) return;
    f32x4 acc[2][2][4][2];
#pragma unroll
    for (int a = 0; a < 2; ++a)
#pragma unroll
        for (int b = 0; b < 2; ++b)
#pragma unroll
            for (int m = 0; m < 4; ++m)
#pragma unroll
                for (int n = 0; n < 2; ++n) acc[a][b][m][n] = (f32x4){0.f, 0.f, 0.f, 0.f};
    bf16x8 At[4][2], B0[2][2], B1[2][2];
    const char* cA = (const char*)g.A + (size_t)cur.pm * tstep; const char* cB = (const char*)g.Bt + (size_t)cur.pn * tstep;
    S.a_ready(cur);
    if constexpr (SP2) {
        PG8_STAGE(PG8_SB(0, 0), cB, voffB); PG8_STAGE(PG8_SB(0, 1), cB + hstep, voffB); PG8_STAGE(PG8_SA(0, 0), cA, voffA); PG8_STAGE(PG8_SA(0, 1), cA + hstep, voffA);
        if (wr == 1) PG8_BAR;
        PG8_WAIT_V(2); PG8_BAR;
        PG8_STAGE(PG8_SB(1, 0), cB + kstep, voffB); PG8_STAGE(PG8_SA(1, 0), cA + kstep, voffA); PG8_STAGE(PG8_SB(1, 1), cB + hstep + kstep, voffB);
        PG8_WAIT_V(6); PG8_BAR;
    } else {
        PG8_STAGE(PG8_SB(0, 0), cB, voffB); PG8_STAGE(PG8_SA(0, 0), cA, voffA); PG8_STAGE(PG8_SB(0, 1), cB + hstep, voffB); PG8_STAGE(PG8_SA(0, 1), cA + hstep, voffA);
        if (wr == 1) PG8_BAR;
        PG8_WAIT_V(4); PG8_BAR;
        PG8_STAGE(PG8_SB(1, 0), cB + kstep, voffB); PG8_STAGE(PG8_SA(1, 0), cA + kstep, voffA); PG8_STAGE(PG8_SB(1, 1), cB + hstep + kstep, voffB);
        PG8_WAIT_V(6); PG8_BAR;
    }
    for (;;) {
        const bool has_next = S.next(ui + 1, nxt);
        const char* nA = has_next ? (const char*)g.A + (size_t)nxt.pm * tstep : cA; const char* nB = has_next ? (const char*)g.Bt + (size_t)nxt.pn * tstep : cB;
        for (int t = 0; t < nt; t += 2) {
            const bool last = (t == nt - 2);
            const char* a1 = cA + (size_t)(t + 1) * kstep;
            const char* a2 = last ? nA : cA + (size_t)(t + 2) * kstep; const char* b2 = last ? nB : cB + (size_t)(t + 2) * kstep;
            const char* a3 = a2 + kstep; const char* b3 = b2 + kstep;
            if (last && has_next) S.a_ready(nxt);
            if constexpr (SP2) {
            PG8_LDB(B0, 0, 0); PG8_LDB(B1, 0, 1); PG8_SCHED; PG8_LDA(At, 0, 0); PG8_STAGE(PG8_SA(1, 1), a1 + hstep, voffA);
            PG8_WAIT_V(8); PG8_WAIT_L(0); PG8_BAR; PG8_MMA(0, 0, At, B0); PG8_MMA(0, 1, At, B1); PG8_BAR; PG8_SCHED;
            PG8_LDA(At, 0, 1); PG8_STAGE(PG8_SB(0, 0), b2, voffB); PG8_STAGE(PG8_SB(0, 1), b2 + hstep, voffB); PG8_STAGE(PG8_SA(0, 0), a2, voffA);
            PG8_WAIT_V(8); PG8_WAIT_L(0); PG8_BAR; PG8_MMA(1, 0, At, B0); PG8_MMA(1, 1, At, B1); PG8_BAR; PG8_SCHED;
            PG8_LDB(B0, 1, 0); PG8_LDB(B1, 1, 1); PG8_SCHED; PG8_LDA(At, 1, 0); PG8_STAGE(PG8_SA(0, 1), a2 + hstep, voffA);
            PG8_WAIT_V(8); PG8_WAIT_L(0); PG8_BAR; PG8_MMA(0, 0, At, B0); PG8_MMA(0, 1, At, B1); PG8_BAR; PG8_SCHED;
            PG8_LDA(At, 1, 1); PG8_STAGE(PG8_SB(1, 0), b3, voffB); PG8_STAGE(PG8_SB(1, 1), b3 + hstep, voffB); PG8_STAGE(PG8_SA(1, 0), a3, voffA);
            PG8_WAIT_V(8); PG8_WAIT_L(0); PG8_BAR; PG8_MMA(1, 0, At, B0); PG8_MMA(1, 1, At, B1); PG8_BAR; PG8_SCHED;
            } else {
            PG8_LDB(B0, 0, 0); PG8_SCHED; PG8_LDA(At, 0, 0); PG8_STAGE(PG8_SA(1, 1), a1 + hstep, voffA);
            PG8_WAIT_L(8); PG8_BAR; PG8_WAIT_L(0); PG8_MMA(0, 0, At, B0); PG8_BAR; PG8_SCHED;
            PG8_LDB(B1, 0, 1); PG8_STAGE(PG8_SB(0, 0), b2, voffB);
            PG8_BAR; PG8_WAIT_L(0); PG8_MMA(0, 1, At, B1); PG8_BAR;
            PG8_LDA(At, 0, 1); PG8_STAGE(PG8_SA(0, 0), a2, voffA);
            PG8_BAR; PG8_WAIT_L(0); PG8_MMA(1, 0, At, B0); PG8_BAR; PG8_SCHED;
            PG8_STAGE(PG8_SB(0, 1), b2 + hstep, voffB);
            PG8_WAIT_V(6); PG8_BAR; PG8_MMA(1, 1, At, B1); PG8_BAR;
            PG8_LDB(B0, 1, 0); PG8_SCHED; PG8_LDA(At, 1, 0); PG8_STAGE(PG8_SA(0, 1), a2 + hstep, voffA);
            PG8_WAIT_L(8); PG8_BAR; PG8_WAIT_L(0); PG8_MMA(0, 0, At, B0); PG8_BAR; PG8_SCHED;
            PG8_LDB(B1, 1, 1); PG8_STAGE(PG8_SB(1, 0), b3, voffB);
            PG8_BAR; PG8_WAIT_L(0); PG8_MMA(0, 1, At, B1); PG8_BAR;
            PG8_LDA(At, 1, 1); PG8_STAGE(PG8_SA(1, 0), a3, voffA);
            PG8_BAR; PG8_WAIT_L(0); PG8_MMA(1, 0, At, B0); PG8_BAR; PG8_SCHED;
            PG8_STAGE(PG8_SB(1, 1), b3 + hstep, voffB);
            PG8_WAIT_V(6); PG8_BAR; PG8_MMA(1, 1, At, B1); PG8_BAR;
            }
        }
        if constexpr (ALIGN_EPI) { if (wr == 0) PG8_BAR; }
        if constexpr (!Epi::AFTER_DRAIN) { E(acc, cur, wr, wc, fr, fq); S.done(cur); }
        if (!has_next) break;
#pragma unroll
        for (int a = 0; a < 2; ++a)
#pragma unroll
            for (int b = 0; b < 2; ++b)
#pragma unroll
                for (int m = 0; m < 4; ++m)
#pragma unroll
                    for (int n = 0; n < 2; ++n) acc[a][b][m][n] = (f32x4){0.f, 0.f, 0.f, 0.f};
        cur = nxt; cA = nA; cB = nB; ++ui;
        if constexpr (ALIGN_EPI) { if (wr == 1) PG8_BAR; }
    }
    PG8_WAIT_V(0);
    if constexpr (!ALIGN_EPI) { if (wr == 0) PG8_BAR; }
    PG8_BAR;
    if constexpr (Epi::AFTER_DRAIN) { E.fused(acc, cur, wr, wc, fr, fq, lds, wid, lane); S.done(cur); }
#undef PG8_SA
#undef PG8_SB
#undef PG8_STAGE
#undef PG8_LDA
#undef PG8_LDB
#undef PG8_MMA
#undef PG8_WAIT_V
#undef PG8_WAIT_L
#undef PG8_BAR
#undef PG8_SCHED
}
}

constexpr int DM = 1024, BATCH = 16, SEQ = 2048, M = BATCH * SEQ, DEPTH = 2, NIN = 2560, FF = 2816, NUP = 2 * FF, PROJW = 2048, NMOD = 6 * DM;
constexpr float EPS = 1e-6f;
constexpr int NWAVES = 8, NTHR = 512;
constexpr size_t MiB = 1u << 20;
constexpr size_t WS_WIN = 0, WS_WOUT = 10 * MiB, WS_WUP = 14 * MiB, WS_WDN = 36 * MiB, WS_WSB = 47 * MiB, WS_MOD = 48 * MiB, WS_CTL = 49 * MiB, CTL_BYTES = 16384;
constexpr size_t WS_H = 64 * MiB, WS_PROJ = 128 * MiB, WS_Y = 256 * MiB, WS_ACT = 128 * MiB  , WS_X1 = 320 * MiB, WS_END = 448 * MiB;
static_assert(WS_ACT + (size_t)M * FF * 2 <= WS_X1 && WS_PROJ + (size_t)M * PROJW * 2 <= WS_Y && WS_Y + (size_t)M * DM * 2 <= WS_X1, "ws map");
constexpr int VL_STRIDE = 68, VL_WAVE_BYTES = 128 * VL_STRIDE * 2, SSQV_OFF = 8 * VL_WAVE_BYTES, RSV_OFF = SSQV_OFF + 4096, SSQ2_OFF = RSV_OFF + 512, RSW_OFF = SSQ2_OFF + 4096  , LDS_BYTES = 152 * 1024, MISC_OFF = LDS_BYTES - 64;
static_assert(RSW_OFF + 4096 <= LDS_BYTES - 64, "lds map");

#define LAS __attribute__((address_space(3)))
typedef unsigned short bf16;
typedef unsigned v4u __attribute__((ext_vector_type(4)));
typedef unsigned v2u __attribute__((ext_vector_type(2)));
typedef float f32x4 __attribute__((ext_vector_type(4)));
typedef float f32x16 __attribute__((ext_vector_type(16)));
typedef short bf16x8 __attribute__((ext_vector_type(8)));
#define LDS_WAIT() asm volatile("s_waitcnt lgkmcnt(0)" ::: "memory")
__device__ __forceinline__ unsigned f2bf(float f) { unsigned u = __builtin_bit_cast(unsigned, f); return (u + 0x7fffu + ((u >> 16) & 1u)) >> 16; }
__device__ __forceinline__ unsigned pk2(float lo, float hi) { return f2bf(lo) | (f2bf(hi) << 16); }
__device__ __forceinline__ float bflo(unsigned w) { return __builtin_bit_cast(float, w << 16); }
__device__ __forceinline__ float bfhi(unsigned w) { return __builtin_bit_cast(float, w & 0xffff0000u); }
__device__ __forceinline__ float wave_sum(float v) {
#pragma unroll
    for (int o = 1; o < 64; o <<= 1) v += __shfl_xor(v, o);
    return v;
}

#define XB_TMO      128
#define XB_XCNT(j)  (256  + 64 * (j))
#define XB_XSUB(j)  (1280 + 64 * (j))
#define XB_XGEN(j)  (2304 + 64 * (j))
#define XB_TOP      3328
#define XB_TOPGEN   3392
#define XCD_BAR_WORDS 3456
#define XB_SPIN_CAP (1u << 18)

__device__ __forceinline__ unsigned xb_ld(unsigned* p)              { return __hip_atomic_load(p, __ATOMIC_RELAXED, __HIP_MEMORY_SCOPE_AGENT); }
__device__ __forceinline__ unsigned xb_add(unsigned* p, unsigned v) { return __hip_atomic_fetch_add(p, v, __ATOMIC_RELAXED, __HIP_MEMORY_SCOPE_AGENT); }
__device__ __forceinline__ unsigned xb_xcc_id() { return (unsigned)__builtin_amdgcn_s_getreg((3 << 11) | 20) & 0xFu; }
#define XB_SPIN(cond, bar) do { unsigned _sp = 0; while (cond) { __builtin_amdgcn_s_sleep(1); \
    if ((++_sp & 255u) == 0u) { if (xb_ld(&(bar)[XB_TMO])) break; if (_sp > XB_SPIN_CAP) { atomicAdd(&(bar)[XB_TMO], 1u); break; } } } } while (0)

struct XcdBarrier {
    unsigned* bar; unsigned x;
    volatile LAS unsigned* st;
};

__device__ __forceinline__ XcdBarrier xcd_barrier_post(unsigned* bar, volatile LAS unsigned* st) {
    XcdBarrier b; b.bar = bar; b.x = xb_xcc_id(); b.st = st;
    if (threadIdx.x == 0) (void)xb_add(&bar[XB_XCNT(b.x)], 1u);
    return b;
}
__device__ __forceinline__ void xcd_barrier_complete(unsigned* bar, unsigned x, unsigned& nloc, unsigned& nx) {
    const unsigned G = gridDim.x * gridDim.y * gridDim.z;
    unsigned sum, cnt, mine, sp = 0u;
    for (;;) {
        sum = 0u; cnt = 0u; mine = 0u;
#pragma unroll
        for (unsigned j = 0; j < 16; ++j) { const unsigned c = xb_ld(&bar[XB_XCNT(j)]); sum += c; cnt += (c > 0u) ? 1u : 0u; mine = (j == x) ? c : mine; }
        if (sum == G) break;
        __builtin_amdgcn_s_sleep(1);
        if ((++sp & 255u) == 0u) { if (xb_ld(&bar[XB_TMO])) break; if (sp > XB_SPIN_CAP) { atomicAdd(&bar[XB_TMO], 1u); break; } }
    }
    nloc = mine > 0u ? mine : 1u; nx = cnt > 0u ? cnt : 1u;
}

__device__ __forceinline__ void xcd_barrier(const XcdBarrier& b) {
    asm volatile("s_waitcnt vmcnt(0)" ::: "memory");
    __syncthreads();
    if (threadIdx.x == 0) {
        unsigned* bar = b.bar; unsigned bx = b.x; asm volatile("" : "+s"(bar), "+s"(bx));
        __builtin_amdgcn_s_waitcnt(0);
        unsigned nloc = b.st[0], nx = b.st[1];
        if (nloc == 0u) { xcd_barrier_complete(bar, bx, nloc, nx); b.st[0] = nloc; b.st[1] = nx; }
        const unsigned old = xb_add(&bar[XB_XSUB(bx)], 1u);
        const unsigned gen = old / nloc;
        if (old + 1u == (gen + 1u) * nloc) {
            __builtin_amdgcn_fence(__ATOMIC_RELEASE, "agent");
            asm volatile("s_waitcnt vmcnt(0)" ::: "memory");
            const unsigned og = xb_add(&bar[XB_TOP], 1u);
            const unsigned tg = og / nx;
            if (og + 1u == (tg + 1u) * nx) xb_add(&bar[XB_TOPGEN], 1u);
            else XB_SPIN(xb_ld(&bar[XB_TOPGEN]) == tg, bar);
            __builtin_amdgcn_fence(__ATOMIC_ACQUIRE, "agent");
            xb_add(&bar[XB_XGEN(bx)], 1u);
            asm volatile("s_waitcnt vmcnt(0)" ::: "memory");
        } else {
            XB_SPIN(xb_ld(&bar[XB_XGEN(bx)]) == gen, bar);
            __builtin_amdgcn_fence(__ATOMIC_ACQUIRE, "agent");
            asm volatile("s_waitcnt vmcnt(0)" ::: "memory");
        }
    }
    __syncthreads();
}

struct Params { const float* in[17]; float* out; unsigned char* ws; int ph_lo, ph_hi; };
enum { I_X = 0, I_C, I_WMOD, I_BMOD, I_NMIX, I_WIN, I_CONVW, I_VNORM, I_WS, I_BS, I_ONA, I_ONB, I_WOUT, I_NFFN, I_WUP, I_WDOWN, I_NFINAL };

template <int MAP> __device__ __forceinline__ int src_col(int r) {
    if (MAP == 1) { if (r < 512 || r >= 1536) return r; const int q = r - 512, j = q >> 8, h = (q >> 7) & 1, i = q & 127; return 512 + h * 512 + 128 * j + i; }
    if (MAP == 2) { const int j = r >> 8, h = (r >> 7) & 1, i = r & 127; return h * FF + 128 * j + i; }
    return r;
}
template <int MAP> __device__ __forceinline__ void transpose_item(const float* W, int K, int N, bf16* WT, LAS float* scr, int item, int lane) {
    const int nblk = N / 32, kb = item / nblk, nb = item % nblk, k0 = 64 * kb, r0 = 32 * nb, n0 = src_col<MAP>(r0);
    float tv[32];
#pragma unroll
    for (int i = 0; i < 32; ++i) tv[i] = __builtin_nontemporal_load(W + (size_t)(k0 + 2 * i + (lane >> 5)) * N + n0 + (lane & 31));
#pragma unroll
    for (int i = 0; i < 32; ++i) scr[(2 * i + (lane >> 5)) * 33 + (lane & 31)] = tv[i];
    LDS_WAIT(); asm volatile("" ::: "memory");
    const int c = lane & 7;
#pragma unroll
    for (int j = 0; j < 4; ++j) { const int n = (lane >> 3) + 8 * j; const LAS float* s = scr + (8 * c) * 33 + n;
        v4u o; o.x = pk2(s[0 * 33], s[1 * 33]); o.y = pk2(s[2 * 33], s[3 * 33]); o.z = pk2(s[4 * 33], s[5 * 33]); o.w = pk2(s[6 * 33], s[7 * 33]);
        *(v4u*)(WT + (size_t)(r0 + n) * K + k0 + 8 * c) = o; }
    LDS_WAIT(); asm volatile("" ::: "memory");
}

__device__ __forceinline__ void norm_phase(const float* X, const float* gamma, const float* modl, int sh_off, int sc_off, bf16* Hout, int gw, int NGW, int lane) {
    constexpr int NR = 2;
    f32x4 g[4];
#pragma unroll
    for (int j = 0; j < 4; ++j) g[j] = ((const f32x4*)gamma)[64 * j + lane];
    for (int m0 = gw * NR; m0 < M; m0 += NGW * NR) {
        f32x4 v[NR][4];
#pragma unroll
        for (int r = 0; r < NR; ++r)
#pragma unroll
            for (int j = 0; j < 4; ++j) v[r][j] = __builtin_nontemporal_load((const f32x4*)(X + (size_t)(m0 + r) * DM) + lane + 64 * j);
        const float* mb = modl + (size_t)(m0 >> 11) * NMOD;
        f32x4 sc[4], sh[4];
#pragma unroll
        for (int j = 0; j < 4; ++j) { sc[j] = ((const f32x4*)(mb + sc_off))[64 * j + lane] + 1.0f; sh[j] = ((const f32x4*)(mb + sh_off))[64 * j + lane]; }
#pragma unroll
        for (int r = 0; r < NR; ++r) {
            float s = 0.f;
#pragma unroll
            for (int j = 0; j < 4; ++j) s += (v[r][j].x * v[r][j].x + v[r][j].y * v[r][j].y) + (v[r][j].z * v[r][j].z + v[r][j].w * v[r][j].w);
            const float rs = 1.0f / sqrtf(wave_sum(s) * (1.f / DM) + EPS);
            unsigned long long* o8 = (unsigned long long*)(Hout + (size_t)(m0 + r) * DM) + lane;
#pragma unroll
            for (int j = 0; j < 4; ++j) { const f32x4 o = (v[r][j] * rs) * g[j] * sc[j] + sh[j];
                o8[64 * j] = (unsigned long long)pk2(o.x, o.y) | ((unsigned long long)pk2(o.z, o.w) << 32); }
        }
    }
}

__device__ __forceinline__ void norm_phase_b(const bf16* X, const float* gamma, const float* modl, int sh_off, int sc_off, bf16* Hout, int gw, int NGW, int lane) {
    constexpr int NR = 4;
    f32x4 g[2][2];
#pragma unroll
    for (int j = 0; j < 2; ++j) { g[j][0] = ((const f32x4*)gamma)[2 * (64 * j + lane)]; g[j][1] = ((const f32x4*)gamma)[2 * (64 * j + lane) + 1]; }
    for (int m0 = gw * NR; m0 < M; m0 += NGW * NR) {
        v4u w[NR][2];
#pragma unroll
        for (int r = 0; r < NR; ++r)
#pragma unroll
            for (int j = 0; j < 2; ++j) w[r][j] = ((const v4u*)(X + (size_t)(m0 + r) * DM) + lane)[64 * j];
        const float* mb = modl + (size_t)(m0 >> 11) * NMOD;
        f32x4 sc[2][2], sh[2][2];
#pragma unroll
        for (int j = 0; j < 2; ++j)
#pragma unroll
            for (int q = 0; q < 2; ++q) { sc[j][q] = ((const f32x4*)(mb + sc_off))[2 * (64 * j + lane) + q] + 1.0f; sh[j][q] = ((const f32x4*)(mb + sh_off))[2 * (64 * j + lane) + q]; }
#pragma unroll
        for (int r = 0; r < NR; ++r) {
            f32x4 v[2][2]; float s = 0.f;
#pragma unroll
            for (int j = 0; j < 2; ++j) { const v4u ww = w[r][j];
                v[j][0] = (f32x4){bflo(ww.x), bfhi(ww.x), bflo(ww.y), bfhi(ww.y)}; v[j][1] = (f32x4){bflo(ww.z), bfhi(ww.z), bflo(ww.w), bfhi(ww.w)};
#pragma unroll
                for (int q = 0; q < 2; ++q) s += (v[j][q].x * v[j][q].x + v[j][q].y * v[j][q].y) + (v[j][q].z * v[j][q].z + v[j][q].w * v[j][q].w); }
            const float rs = 1.0f / sqrtf(wave_sum(s) * (1.f / DM) + EPS);
            v4u* o16 = (v4u*)(Hout + (size_t)(m0 + r) * DM) + lane;
#pragma unroll
            for (int j = 0; j < 2; ++j) { f32x4 o[2];
#pragma unroll
                for (int q = 0; q < 2; ++q) o[q] = (v[j][q] * rs) * g[j][q] * sc[j][q] + sh[j][q];
                v4u ow; ow.x = pk2(o[0].x, o[0].y); ow.y = pk2(o[0].z, o[0].w); ow.z = pk2(o[1].x, o[1].y); ow.w = pk2(o[1].z, o[1].w);
                o16[64 * j] = ow; }
        }
    }
}

__device__ __forceinline__ void conv_phase(const bf16* PROJ, const float* convw, const float* ga, bf16* Y, int gw, int NGW, int lane) {
    float w0[8], w1[8], w2[8], gg[8];
#pragma unroll
    for (int e = 0; e < 8; ++e) { w0[e] = convw[8 * lane + e]; w1[e] = convw[512 + 8 * lane + e]; w2[e] = convw[1024 + 8 * lane + e]; gg[e] = ga[8 * lane + e]; }
    for (int run = gw; run < M / 16; run += NGW) {
        const int r0 = run * 16;
        float zm1[8], zm2[8];
        if ((r0 & (SEQ - 1)) == 0) {
#pragma unroll
            for (int e = 0; e < 8; ++e) { zm1[e] = 0.f; zm2[e] = 0.f; }
        } else {
            const v4u a = *(const v4u*)(PROJ + (size_t)(r0 - 1) * PROJW + 512 + 8 * lane), b = *(const v4u*)(PROJ + (size_t)(r0 - 2) * PROJW + 512 + 8 * lane);
            zm1[0] = bflo(a.x); zm1[1] = bfhi(a.x); zm1[2] = bflo(a.y); zm1[3] = bfhi(a.y); zm1[4] = bflo(a.z); zm1[5] = bfhi(a.z); zm1[6] = bflo(a.w); zm1[7] = bfhi(a.w);
            zm2[0] = bflo(b.x); zm2[1] = bfhi(b.x); zm2[2] = bflo(b.y); zm2[3] = bfhi(b.y); zm2[4] = bflo(b.z); zm2[5] = bfhi(b.z); zm2[6] = bflo(b.w); zm2[7] = bfhi(b.w);
        }
#pragma unroll 4
        for (int t = 0; t < 16; ++t) {
            const size_t row = (size_t)(r0 + t);
            const v4u zr = *(const v4u*)(PROJ + row * PROJW + 512 + 8 * lane), br = *(const v4u*)(PROJ + row * PROJW + 8 * lane);
            float zc[8], bg[8], ya[8];
            zc[0] = bflo(zr.x); zc[1] = bfhi(zr.x); zc[2] = bflo(zr.y); zc[3] = bfhi(zr.y); zc[4] = bflo(zr.z); zc[5] = bfhi(zr.z); zc[6] = bflo(zr.w); zc[7] = bfhi(zr.w);
            bg[0] = bflo(br.x); bg[1] = bfhi(br.x); bg[2] = bflo(br.y); bg[3] = bfhi(br.y); bg[4] = bflo(br.z); bg[5] = bfhi(br.z); bg[6] = bflo(br.w); bg[7] = bfhi(br.w);
            float s = 0.f;
#pragma unroll
            for (int e = 0; e < 8; ++e) { ya[e] = bg[e] * (w0[e] * zm2[e] + w1[e] * zm1[e] + w2[e] * zc[e]); s += ya[e] * ya[e]; zm2[e] = zm1[e]; zm1[e] = zc[e]; }
            const float rs = 1.0f / sqrtf(wave_sum(s) * (1.f / 512.f) + EPS);
            v4u o; o.x = pk2(ya[0] * rs * gg[0], ya[1] * rs * gg[1]); o.y = pk2(ya[2] * rs * gg[2], ya[3] * rs * gg[3]);
            o.z = pk2(ya[4] * rs * gg[4], ya[5] * rs * gg[5]); o.w = pk2(ya[6] * rs * gg[6], ya[7] * rs * gg[7]);
            *(v4u*)(Y + row * DM + 8 * lane) = o;
        }
    }
}

__device__ __forceinline__ void sgu_phase(LAS unsigned char* lds, const bf16* PROJp, const bf16* Wsb  , const float* vnorm, const float* bs, const float* gb, bf16* Yp,
                                          int tid, int wave, int lane) {
    const int h = wave;
    LAS bf16* VL = (LAS bf16*)(lds + h * VL_WAVE_BYTES);
    LAS float* SSQV = (LAS float*)(lds + SSQV_OFF);
    LAS float* RSV = (LAS float*)(lds + RSV_OFF);
    LAS float* SSQ2 = (LAS float*)(lds + SSQ2_OFF);
    const int r8 = lane >> 3, c8 = lane & 7, il = lane & 31, kg = lane >> 5;
    LAS float* const ssqv_w = SSQV + h * 128 + r8; LAS float* const rsv_r = RSV + r8; LAS bf16* const vl_rc = VL + r8 * VL_STRIDE + 8 * c8;
    LAS bf16* const vl_id = VL + il * VL_STRIDE + 4 * kg; LAS float* const ssq2_w = SSQ2 + h * 128 + il; LAS float* const rsw = (LAS float*)(lds + RSW_OFF) + h * 128;
    const unsigned voff_row = (unsigned)(r8 * PROJW + 8 * c8) * 2u;
    const unsigned voff_gu = (unsigned)(il * PROJW + 4 * kg) * 2u;
    const unsigned voff_w = (unsigned)(il * 128 + 8 * kg) * 2u;
    const unsigned voff_y = (unsigned)(r8 * DM + 8 * c8) * 2u;
    const char* const wbase = (const char*)(Wsb + (size_t)h * 128 * 128);
    const char* const vnb = (const char*)(vnorm + 64 * h);
    int item = blockIdx.x;
    if (item >= M / 128) return;
    for (;;) {
        const size_t t0 = (size_t)item * 128;
        v4u raw[16];
        { const char* vb = (const char*)(PROJp + t0 * PROJW + 1536 + 64 * h); unsigned vr = voff_row; asm volatile("" : "+v"(vr));
#pragma unroll
          for (int it = 0; it < 16; ++it) raw[it] = *(const v4u*)(vb + (size_t)it * (8 * PROJW * 2) + vr); }
#pragma unroll
        for (int it = 0; it < 16; ++it) {
            const v4u a = raw[it];
            float s = (bflo(a.x) * bflo(a.x) + bfhi(a.x) * bfhi(a.x)) + (bflo(a.y) * bflo(a.y) + bfhi(a.y) * bfhi(a.y)) + (bflo(a.z) * bflo(a.z) + bfhi(a.z) * bfhi(a.z)) + (bflo(a.w) * bflo(a.w) + bfhi(a.w) * bfhi(a.w));
            s += __shfl_xor(s, 1); s += __shfl_xor(s, 2); s += __shfl_xor(s, 4);
            if (c8 == 0) ssqv_w[8 * it] = s;
        }
        __syncthreads();
        if (tid < 128) { float s = 0.f;
#pragma unroll
            for (int w = 0; w < 8; ++w) s += SSQV[w * 128 + tid];
            RSV[tid] = 1.0f / sqrtf(s * (1.f / 512.f) + EPS); }
        __syncthreads();
#pragma unroll
        for (int it = 0; it < 16; ++it) {
            const float r = rsv_r[8 * it]; const v4u a = raw[it];
            v2u lo, hi; lo.x = pk2(bflo(a.x) * r, bfhi(a.x) * r); lo.y = pk2(bflo(a.y) * r, bfhi(a.y) * r); hi.x = pk2(bflo(a.z) * r, bfhi(a.z) * r); hi.y = pk2(bflo(a.w) * r, bfhi(a.w) * r);
            *(LAS v2u*)(vl_rc + it * 8 * VL_STRIDE) = lo; *(LAS v2u*)(vl_rc + it * 8 * VL_STRIDE + 4) = hi;
        }
        const int nitem = item + (int)gridDim.x; const bool has_next = nitem < M / 128;
        LDS_WAIT(); asm volatile("" ::: "memory");
        bf16x8 vf[8][2];
#pragma unroll
        for (int ks = 0; ks < 8; ++ks)
#pragma unroll
            for (int nb = 0; nb < 2; ++nb)
#pragma unroll
                for (int e = 0; e < 8; ++e) vf[ks][nb][e] = (short)VL[(16 * ks + 8 * kg + e) * VL_STRIDE + 32 * nb + il];
        LDS_WAIT(); asm volatile("" ::: "memory");
#pragma unroll
        for (int mb = 0; mb < 4; ++mb) {
            const int i = 32 * mb + il;
            const char* gub = (const char*)(PROJp + (t0 + 32 * mb) * PROJW + 1024 + 64 * h); unsigned vg = voff_gu, vw = voff_w, vv = (unsigned)(16 * kg); asm volatile("" : "+v"(vg), "+v"(vw), "+v"(vv));
            v2u gu[2][4];
#pragma unroll
            for (int nb = 0; nb < 2; ++nb)
#pragma unroll
                for (int blk = 0; blk < 4; ++blk) gu[nb][blk] = *(const v2u*)(gub + vg + (32 * nb + 8 * blk) * 2);
            f32x16 acc[2];
#pragma unroll
            for (int nb = 0; nb < 2; ++nb)
#pragma unroll
                for (int r = 0; r < 16; ++r) acc[nb][r] = 0.f;
            const char* wb = wbase + (size_t)(32 * mb) * 128 * 2;
#pragma unroll
            for (int ks = 0; ks < 2 * (mb + 1); ++ks) {
                const bf16x8 wf = *(const bf16x8*)(wb + vw + ks * 32);
                acc[0] = __builtin_amdgcn_mfma_f32_32x32x16_bf16(vf[ks][0], wf, acc[0], 0, 0, 0);
                acc[1] = __builtin_amdgcn_mfma_f32_32x32x16_bf16(vf[ks][1], wf, acc[1], 0, 0, 0);
            }
            const float bsv = bs[h * 128 + i];
            float ss = 0.f;
#pragma unroll
            for (int nb = 0; nb < 2; ++nb)
#pragma unroll
                for (int blk = 0; blk < 4; ++blk) {
                    const f32x4 vn = *(const f32x4*)(vnb + vv + (32 * nb + 8 * blk) * 4);
                    const float y0 = bflo(gu[nb][blk].x) * (acc[nb][4 * blk + 0] * vn.x + bsv), y1 = bfhi(gu[nb][blk].x) * (acc[nb][4 * blk + 1] * vn.y + bsv);
                    const float y2 = bflo(gu[nb][blk].y) * (acc[nb][4 * blk + 2] * vn.z + bsv), y3 = bfhi(gu[nb][blk].y) * (acc[nb][4 * blk + 3] * vn.w + bsv);
                    ss += (y0 * y0 + y1 * y1) + (y2 * y2 + y3 * y3);
                    v2u o; o.x = pk2(y0, y1); o.y = pk2(y2, y3);
                    *(LAS v2u*)(vl_id + 32 * mb * VL_STRIDE + 32 * nb + 8 * blk) = o;
                }
            ss += __shfl_xor(ss, 32);
            if (kg == 0) ssq2_w[32 * mb] = ss;
            asm volatile("" ::: "memory");
        }
        __syncthreads();
        const f32x4 g0 = *(const f32x4*)(gb + 64 * h + 8 * c8), g1 = *(const f32x4*)(gb + 64 * h + 8 * c8 + 4);
        float ta = 0.f, tb = 0.f;
#pragma unroll
        for (int w = 0; w < 8; ++w) { ta += SSQ2[w * 128 + lane]; tb += SSQ2[w * 128 + 64 + lane]; }
        rsw[lane] = 1.0f / sqrtf(ta * (1.f / 512.f) + EPS); rsw[64 + lane] = 1.0f / sqrtf(tb * (1.f / 512.f) + EPS);
        LDS_WAIT(); asm volatile("" ::: "memory");
        char* const yb = (char*)(Yp + t0 * DM + 512 + 64 * h); unsigned vy = voff_y; asm volatile("" : "+v"(vy));
#pragma unroll
        for (int it = 0; it < 16; ++it) {
            const float rs = (rsw + r8)[8 * it];
            const v2u lo = *(const LAS v2u*)(vl_rc + it * 8 * VL_STRIDE), hi = *(const LAS v2u*)(vl_rc + it * 8 * VL_STRIDE + 4);
            v4u o; o.x = pk2(bflo(lo.x) * rs * g0.x, bfhi(lo.x) * rs * g0.y); o.y = pk2(bflo(lo.y) * rs * g0.z, bfhi(lo.y) * rs * g0.w);
            o.z = pk2(bflo(hi.x) * rs * g1.x, bfhi(hi.x) * rs * g1.y); o.w = pk2(bflo(hi.y) * rs * g1.z, bfhi(hi.y) * rs * g1.w);
            *(v4u*)(yb + (size_t)it * (8 * DM * 2) + vy) = o;
            if ((it & 3) == 3) asm volatile("" ::: "memory");
        }
        if (!has_next) break;
        item = nitem;
    }
}

constexpr int NPHASE = 16;
__global__ void __launch_bounds__(NTHR, 2) fwd_megakernel(Params p) {
    extern __shared__ __attribute__((aligned(16))) unsigned char lds_raw[];
    LAS unsigned char* lds = (LAS unsigned char*)lds_raw;
    const int G = gridDim.x, NGW = G * NWAVES;
#define LANE_IDS() int tid_l = threadIdx.x; asm volatile("" : "+v"(tid_l)); const int tid = tid_l, lane = tid & 63, wave = __builtin_amdgcn_readfirstlane(tid >> 6), gw = blockIdx.x * NWAVES + wave; (void)lane; (void)gw; (void)tid; KARG_BASE()
    typedef const __attribute__((address_space(4))) unsigned long long* kargp_t;
#define KARG_BASE() kargp_t ka_ = (kargp_t)__builtin_amdgcn_kernarg_segment_ptr(); asm volatile("" : "+s"(ka_)); unsigned char* const ws = (unsigned char*)ka_[18]; (void)ws
#define PIN(i) ((const float*)ka_[i])
#define POUT ((float*)ka_[17])
#define MOD ((float*)(ws + WS_MOD))
#define H ((bf16*)(ws + WS_H))
#define PROJ ((bf16*)(ws + WS_PROJ))
#define Y ((bf16*)(ws + WS_Y))
#define ACT ((bf16*)(ws + WS_ACT))
#define X1 ((bf16*)(ws + WS_X1))
#ifdef DIAG_ONLY
#define IN(k) (((k) == DIAG_ONLY))
#else
#define IN(k) (true)
#endif
    if (threadIdx.x < 16) ((LAS unsigned*)(lds + MISC_OFF))[threadIdx.x] = 0u;
    __syncthreads();
    XcdBarrier bar; { KARG_BASE(); bar = xcd_barrier_post((unsigned*)(ws + WS_CTL), (volatile LAS unsigned*)(lds + MISC_OFF)); }
#ifndef PROBE_MASK
#define PROBE_MASK 0
#endif
#define REPS(k) for (int rep_ = 0; rep_ <= ((PROBE_MASK >> (k)) & 1); ++rep_)
#define REP_BAR() do { if (rep_) xcd_barrier(bar); } while (0)
#define SEAM(k) do { if (IN(k) && IN((k) + 1)) xcd_barrier(bar); } while (0)

    if (IN(0)) REPS(0) {
        REP_BAR();
        LANE_IDS();
        LAS float* scr = (LAS float*)(lds + wave * 16384);
        constexpr int I_IN = 16 * (NIN / 32), I_OUT = 16 * (DM / 32), I_UP = 16 * (NUP / 32), I_DN = (FF / 64) * (DM / 32), I_L = I_IN + I_OUT + I_UP + I_DN;
        for (int it = gw; it < DEPTH * I_L; it += NGW) {
            const int l = it / I_L; int r = it % I_L;
            if (r < I_IN) { transpose_item<1>(PIN(I_WIN) + (size_t)l * DM * NIN, DM, NIN, (bf16*)(ws + WS_WIN) + (size_t)l * NIN * DM, scr, r, lane); continue; } r -= I_IN;
            if (r < I_OUT) { transpose_item<0>(PIN(I_WOUT) + (size_t)l * DM * DM, DM, DM, (bf16*)(ws + WS_WOUT) + (size_t)l * DM * DM, scr, r, lane); continue; } r -= I_OUT;
            if (r < I_UP) { transpose_item<2>(PIN(I_WUP) + (size_t)l * DM * NUP, DM, NUP, (bf16*)(ws + WS_WUP) + (size_t)l * NUP * DM, scr, r, lane); continue; } r -= I_UP;
            transpose_item<0>(PIN(I_WDOWN) + (size_t)l * FF * DM, FF, DM, (bf16*)(ws + WS_WDN) + (size_t)l * DM * FF, scr, r, lane);
        }
        { bf16* Wsb = (bf16*)(ws + WS_WSB); const float* wsrc = PIN(I_WS);
          for (int e = blockIdx.x * NTHR + tid; e < DEPTH * 8 * 128 * 128; e += G * NTHR) { const int j = e & 127, i = (e >> 7) & 127; Wsb[e] = (bf16)(j <= i ? f2bf(wsrc[e]) : 0u); } }
        __syncthreads();
        for (int item = blockIdx.x; item < DEPTH * (NMOD / 64); item += G) {
            const int l = item / (NMOD / 64), col0 = (item % (NMOD / 64)) * 64;
            LAS float* cact = (LAS float*)lds;
            LAS float* red = (LAS float*)(lds + 65536);
            for (int idx = tid; idx < BATCH * DM; idx += NTHR) { const int b = idx >> 10, k = idx & 1023; const float cv = PIN(I_C)[idx]; cact[k * 16 + b] = cv / (1.0f + expf(-cv)); }
            __syncthreads();
            float a[16];
#pragma unroll
            for (int b = 0; b < 16; ++b) a[b] = 0.f;
            const float* wp = PIN(I_WMOD) + (size_t)l * DM * NMOD + (size_t)(wave * 128) * NMOD + col0 + lane;
            for (int k0 = 0; k0 < 128; k0 += 32) {
            float wv32[32];
#pragma unroll
            for (int kk = 0; kk < 32; ++kk) wv32[kk] = __builtin_nontemporal_load(wp + (size_t)(k0 + kk) * NMOD);
#pragma unroll
            for (int kk = 0; kk < 32; ++kk) { const int k = k0 + kk;
                const float wv = wv32[kk];
                const LAS f32x4* cr = (const LAS f32x4*)(cact + (wave * 128 + k) * 16);
                const f32x4 c0 = cr[0], c1 = cr[1], c2 = cr[2], c3 = cr[3];
                a[0] += c0.x * wv; a[1] += c0.y * wv; a[2] += c0.z * wv; a[3] += c0.w * wv; a[4] += c1.x * wv; a[5] += c1.y * wv; a[6] += c1.z * wv; a[7] += c1.w * wv;
                a[8] += c2.x * wv; a[9] += c2.y * wv; a[10] += c2.z * wv; a[11] += c2.w * wv; a[12] += c3.x * wv; a[13] += c3.y * wv; a[14] += c3.z * wv; a[15] += c3.w * wv;
            }
            }
#pragma unroll
            for (int b = 0; b < 16; ++b) red[(wave * 16 + b) * 64 + lane] = a[b];
            __syncthreads();
            for (int o = tid; o < 16 * 64; o += NTHR) { const int b = o >> 6, cc = o & 63; float s = PIN(I_BMOD)[l * NMOD + col0 + cc];
#pragma unroll
                for (int w = 0; w < 8; ++w) s += red[(w * 16 + b) * 64 + cc];
                MOD[((size_t)l * BATCH + b) * NMOD + col0 + cc] = s; }
            __syncthreads();
        }
    }
    SEAM(0);

#ifndef PROBE_LAYER
#define PROBE_LAYER 0
#endif
    for (int li = 0; li < DEPTH + PROBE_LAYER; ++li) {
        const int l = (li <= PROBE_LAYER) ? 0 : li - PROBE_LAYER;
        const int P = 1 + 7 * l;
#define modl (MOD + (size_t)l * BATCH * NMOD)
        if (IN(P + 0)) REPS(P + 0) { REP_BAR(); LANE_IDS(); if (l == 0) norm_phase(PIN(I_X), PIN(I_NMIX) + l * DM, modl, 0 * DM, 1 * DM, H, gw, NGW, lane); else norm_phase_b(X1, PIN(I_NMIX) + l * DM, modl, 0 * DM, 1 * DM, H, gw, NGW, lane); }
        SEAM(P + 0);
        if (IN(P + 1)) REPS(P + 1) {
            REP_BAR();
            KARG_BASE();
            pg8::Gemm g{H, (const bf16*)(ws + WS_WIN) + (size_t)l * NIN * DM, M, NIN, DM}; pg8::StaticOrder S; S.init(M, NIN, G, (int)blockIdx.x);
            pg8::EpiProj E{PROJ};
            pg8::gemm_phase<pg8::EpiProj, pg8::StaticOrder, true, true>(lds, g, S, E);
        }
        SEAM(P + 1);
        if (IN(P + 2)) REPS(P + 2) {
            REP_BAR();
            LANE_IDS();
            sgu_phase(lds, PROJ, (const bf16*)(ws + WS_WSB) + (size_t)l * 8 * 128 * 128, PIN(I_VNORM) + l * 512, PIN(I_BS) + l * 8 * 128, PIN(I_ONB) + l * 512, Y, tid, wave, lane);
            conv_phase(PROJ, PIN(I_CONVW) + l * 3 * 512, PIN(I_ONA) + l * 512, Y, gw, NGW, lane);
        }
        SEAM(P + 2);
        if (IN(P + 3)) REPS(P + 3) {
            REP_BAR();
            KARG_BASE();
            pg8::Gemm g{Y, (const bf16*)(ws + WS_WOUT) + (size_t)l * DM * DM, M, DM, DM}; pg8::StaticOrder S; S.init(M, DM, G, (int)blockIdx.x);
            if (l == 0) { pg8::EpiResB<true> E{PIN(I_X), X1, modl + 2 * DM, NMOD}; pg8::gemm_phase<pg8::EpiResB<true>, pg8::StaticOrder, true, true>(lds, g, S, E); }
            else { pg8::EpiResB<false> E{X1, X1, modl + 2 * DM, NMOD}; pg8::gemm_phase<pg8::EpiResB<false>, pg8::StaticOrder, true, true>(lds, g, S, E); }
        }
        SEAM(P + 3);
        if (IN(P + 4)) REPS(P + 4) { REP_BAR(); LANE_IDS(); norm_phase_b(X1, PIN(I_NFFN) + l * DM, modl, 3 * DM, 4 * DM, H, gw, NGW, lane); }
        SEAM(P + 4);
        if (IN(P + 5)) REPS(P + 5) {
            REP_BAR();
            KARG_BASE();
            pg8::Gemm g{H, (const bf16*)(ws + WS_WUP) + (size_t)l * NUP * DM, M, NUP, DM}; pg8::StaticOrder S; S.init(M, NUP, G, (int)blockIdx.x);
            pg8::EpiSwiGLU E{ACT, FF};
            pg8::gemm_phase<pg8::EpiSwiGLU, pg8::StaticOrder, true, true>(lds, g, S, E);
        }
        SEAM(P + 5);
        if (IN(P + 6)) REPS(P + 6) {
            REP_BAR();
            KARG_BASE();
            pg8::Gemm g{ACT, (const bf16*)(ws + WS_WDN) + (size_t)l * DM * FF, M, DM, FF}; pg8::StaticOrder S; S.init(M, DM, G, (int)blockIdx.x);
            pg8::EpiResB<false> E{X1, X1, modl + 5 * DM, NMOD};
            pg8::gemm_phase<pg8::EpiResB<false>, pg8::StaticOrder, true, true>(lds, g, S, E);
        }
        SEAM(P + 6);
    }
    if (IN(15)) {
        LANE_IDS();
        constexpr int NR = 4;
        f32x4 g[2][2];
#pragma unroll
        for (int j = 0; j < 2; ++j) { g[j][0] = ((const f32x4*)PIN(I_NFINAL))[2 * (64 * j + lane)]; g[j][1] = ((const f32x4*)PIN(I_NFINAL))[2 * (64 * j + lane) + 1]; }
        for (int m0 = gw * NR; m0 < M; m0 += NGW * NR) {
            v4u w[NR][2];
#pragma unroll
            for (int r = 0; r < NR; ++r)
#pragma unroll
                for (int j = 0; j < 2; ++j) w[r][j] = ((const v4u*)(X1 + (size_t)(m0 + r) * DM) + lane)[64 * j];
#pragma unroll
            for (int r = 0; r < NR; ++r) {
                f32x4 v[2][2]; float s = 0.f;
#pragma unroll
                for (int j = 0; j < 2; ++j) { const v4u ww = w[r][j];
                    v[j][0] = (f32x4){bflo(ww.x), bfhi(ww.x), bflo(ww.y), bfhi(ww.y)}; v[j][1] = (f32x4){bflo(ww.z), bfhi(ww.z), bflo(ww.w), bfhi(ww.w)};
#pragma unroll
                    for (int q = 0; q < 2; ++q) s += (v[j][q].x * v[j][q].x + v[j][q].y * v[j][q].y) + (v[j][q].z * v[j][q].z + v[j][q].w * v[j][q].w); }
                const float rs = 1.0f / sqrtf(wave_sum(s) * (1.f / DM) + EPS);
                f32x4* orow = (f32x4*)(POUT + (size_t)(m0 + r) * DM);
#pragma unroll
                for (int j = 0; j < 2; ++j)
#pragma unroll
                    for (int q = 0; q < 2; ++q) __builtin_nontemporal_store((v[j][q] * rs) * g[j][q], orow + 2 * (64 * j + lane) + q);
            }
        }
    }
#undef IN
#undef SEAM
}

#undef MOD
#undef H
#undef PROJ
#undef Y
#undef ACT
#undef X1
#undef modl
#undef xin
extern "C" void kernel_launch(void* const* d_in, const int* in_sizes, int n_in, void* d_out, int out_size, void* d_ws, size_t ws_size, hipStream_t stream) {
    static int grid = 0;
    if (grid == 0) {
        if (n_in != 17 || in_sizes[0] != M * DM || out_size != M * DM || ws_size < WS_END) { fprintf(stderr, "kernel_launch: unexpected shapes (n_in %d, in0 %d, out %d, ws %zu); nothing launched\n", n_in, n_in > 0 ? in_sizes[0] : -1, out_size, ws_size); grid = -1; return; }
        int dev = 0, cus = 0, per_cu = 0;
        hipGetDevice(&dev); hipDeviceGetAttribute(&cus, hipDeviceAttributeMultiprocessorCount, dev);
        if (hipFuncSetAttribute((const void*)fwd_megakernel, hipFuncAttributeMaxDynamicSharedMemorySize, LDS_BYTES) != hipSuccess) { fprintf(stderr, "kernel_launch: hipFuncSetAttribute failed\n"); grid = -1; return; }
        if (hipOccupancyMaxActiveBlocksPerMultiprocessor(&per_cu, (const void*)fwd_megakernel, NTHR, LDS_BYTES) != hipSuccess || per_cu < 1) { fprintf(stderr, "kernel_launch: occupancy query says %d blocks per CU; nothing launched\n", per_cu); (void)hipGetLastError(); grid = -1; return; }
        grid = cus * (per_cu > 1 ? 1 : per_cu);
    }
    if (grid < 0) return;
    if (hipMemsetAsync((char*)d_ws + WS_CTL, 0, CTL_BYTES, stream) != hipSuccess) { fprintf(stderr, "kernel_launch: hipMemsetAsync failed\n"); return; }
    Params p{};
    for (int i = 0; i < 17; ++i) p.in[i] = (const float*)d_in[i];
    p.out = (float*)d_out; p.ws = (unsigned char*)d_ws;
    p.ph_lo = 0; p.ph_hi = NPHASE;
    void* args[] = {&p};
    hipError_t e = hipLaunchCooperativeKernel((const void*)fwd_megakernel, dim3(grid), dim3(NTHR), args, LDS_BYTES, stream);
    if (e != hipSuccess) fprintf(stderr, "cooperative launch failed: %s (grid %d)\n", hipGetErrorString(e), grid);
}
```

```cpp
#include <hip/hip_runtime.h>
#include <hip/hip_cooperative_groups.h>
#include <cstdio>
#include <cstdint>
namespace cg = cooperative_groups;
#define MK_PER_PHASE 0
#define PROBE_MASK 0
#define PROBE_LAYER 0
namespace pg8 {
#define PG8_LAS __attribute__((address_space(3)))
typedef unsigned short bf16_t;
typedef short bf16x8 __attribute__((ext_vector_type(8)));
typedef float f32x4 __attribute__((ext_vector_type(4)));
typedef unsigned u32x4 __attribute__((ext_vector_type(4)));
constexpr int BM = 256, BK = 64, HALF = 128, HTB = HALF * BK * 2  , STAGE_BYTES = 8 * HTB, NXCD = 8, WGM = 4;

__host__ __device__ __forceinline__ int lds_byte(int r, int c) { const int st = (r >> 4) * 2 + (c >> 5), rr = r & 15, cc = c & 31, ob = rr * 64 + cc * 2; return st * 1024 + (ob ^ (((ob >> 9) & 1) << 5)); }
__host__ __device__ __forceinline__ void stage_rc(int b, int& R, int& C) { const int st = b / 1024, sb = b % 1024, swz = sb ^ (((sb >> 9) & 1) << 5); R = (st >> 1) * 16 + swz / 64; C = (st & 1) * 32 + (swz % 64) / 2; }
__host__ __device__ __forceinline__ int perm32(int rho) { const int n = rho >> 4, i = rho & 15; return 8 * (i >> 2) + 4 * n + (i & 3); }

struct Unit { int pm, pn; };
struct Gemm { const bf16_t* A; const bf16_t* Bt; int M, N, K; };

struct StaticOrder {
    int nM, nN, nwg, G, c;
    __host__ __device__ void init(int M, int N, int G_, int c_) { nM = M / BM; nN = N / BM; nwg = nM * nN; G = G_; c = c_; }
    __host__ __device__ bool next(int i, Unit& u) const {
        const long L = (long)i * G + c; if (L >= nwg) return false;
        int wgid = (int)L; { const int q = nwg / NXCD, r = nwg % NXCD, xcd = wgid % NXCD, off = wgid / NXCD; wgid = (xcd < r ? xcd * (q + 1) : r * (q + 1) + (xcd - r) * q) + off; }
        const int nig = WGM * nN, gid = wgid / nig, fm = gid * WGM, gsz = (nM - fm) < WGM ? (nM - fm) : WGM;
        u.pm = fm + ((wgid % nig) % gsz); u.pn = (wgid % nig) / gsz; return true;
    }
    __device__ __forceinline__ void a_ready(const Unit&) const {}
    __device__ __forceinline__ void done(const Unit&) const {}
};


__device__ __forceinline__ unsigned cvt_pk_bf16(float lo, float hi) { unsigned r; asm volatile("v_cvt_pk_bf16_f32 %0, %1, %2" : "=v"(r) : "v"(lo), "v"(hi)); return r; }
__device__ __forceinline__ float gelu_t(float x) {
    const float u2 = x * (1.5957691216f + 0.0713548163f * x * x);
    const float e = __builtin_amdgcn_exp2f(-1.4426950409f * u2);
    return x * __builtin_amdgcn_rcpf(1.0f + e);
}
__device__ __forceinline__ float silu_f(float x) {
    const float e = __builtin_amdgcn_exp2f(-1.4426950409f * x);
    return x * __builtin_amdgcn_rcpf(1.0f + e);
}
struct EpiProj {
    static constexpr bool PERM = true, AFTER_DRAIN = false;
    bf16_t* O;
    __device__ __forceinline__ void operator()(const f32x4 (&acc)[2][2][4][2], const Unit& u, int wr, int wc, int fr, int fq) const {
        const int row0 = u.pm * BM + wr * 64 + fr; const int pn = u.pn;
        if (pn < 2) {
            const int col0 = 256 * pn + wc * 32 + 8 * fq;
#pragma unroll
            for (int ai = 0; ai < 2; ++ai)
#pragma unroll
                for (int m = 0; m < 4; ++m) { bf16_t* rowp = O + (size_t)(row0 + ai * HALF + m * 16) * 2048 + col0;
#pragma unroll
                    for (int bj = 0; bj < 2; ++bj) { const f32x4 v0 = acc[ai][bj][m][0], v1 = acc[ai][bj][m][1];
                        u32x4 w; w.x = cvt_pk_bf16(v0[0], v0[1]); w.y = cvt_pk_bf16(v0[2], v0[3]); w.z = cvt_pk_bf16(v1[0], v1[1]); w.w = cvt_pk_bf16(v1[2], v1[3]);
                        *(u32x4*)(rowp + bj * HALF) = w; } }
        } else if (pn < 6) {
            const int col0 = 512 + 128 * (pn - 2) + wc * 32 + 8 * fq;
#pragma unroll
            for (int ai = 0; ai < 2; ++ai)
#pragma unroll
                for (int m = 0; m < 4; ++m) { bf16_t* rowp = O + (size_t)(row0 + ai * HALF + m * 16) * 2048 + col0;
                    const f32x4 v0 = acc[ai][0][m][0] * acc[ai][1][m][0], v1 = acc[ai][0][m][1] * acc[ai][1][m][1];
                    u32x4 w; w.x = cvt_pk_bf16(v0[0], v0[1]); w.y = cvt_pk_bf16(v0[2], v0[3]); w.z = cvt_pk_bf16(v1[0], v1[1]); w.w = cvt_pk_bf16(v1[2], v1[3]);
                    *(u32x4*)(rowp) = w; }
        } else {
            const int col0 = 1024 + 256 * (pn - 6) + wc * 32 + 8 * fq;
#pragma unroll
            for (int ai = 0; ai < 2; ++ai)
#pragma unroll
                for (int m = 0; m < 4; ++m) { bf16_t* rowp = O + (size_t)(row0 + ai * HALF + m * 16) * 2048 + col0;
#pragma unroll
                    for (int bj = 0; bj < 2; ++bj) { const f32x4 v0 = acc[ai][bj][m][0], v1 = acc[ai][bj][m][1];
                        u32x4 w; w.x = cvt_pk_bf16(gelu_t(v0[0]), gelu_t(v0[1])); w.y = cvt_pk_bf16(gelu_t(v0[2]), gelu_t(v0[3]));
                        w.z = cvt_pk_bf16(gelu_t(v1[0]), gelu_t(v1[1])); w.w = cvt_pk_bf16(gelu_t(v1[2]), gelu_t(v1[3]));
                        *(u32x4*)(rowp + bj * HALF) = w; } }
        }
    }
};
struct EpiSwiGLU {
    static constexpr bool PERM = true, AFTER_DRAIN = false;
    bf16_t* O; int ldc;
    __device__ __forceinline__ void operator()(const f32x4 (&acc)[2][2][4][2], const Unit& u, int wr, int wc, int fr, int fq) const {
        const int row0 = u.pm * BM + wr * 64 + fr; const int col0 = 128 * u.pn + wc * 32 + 8 * fq;
#pragma unroll
        for (int ai = 0; ai < 2; ++ai)
#pragma unroll
            for (int m = 0; m < 4; ++m) { bf16_t* rowp = O + (size_t)(row0 + ai * HALF + m * 16) * ldc + col0;
                const f32x4 g0 = acc[ai][0][m][0], g1 = acc[ai][0][m][1], u0 = acc[ai][1][m][0], u1 = acc[ai][1][m][1];
                u32x4 w; w.x = cvt_pk_bf16(silu_f(g0[0]) * u0[0], silu_f(g0[1]) * u0[1]); w.y = cvt_pk_bf16(silu_f(g0[2]) * u0[2], silu_f(g0[3]) * u0[3]);
                w.z = cvt_pk_bf16(silu_f(g1[0]) * u1[0], silu_f(g1[1]) * u1[1]); w.w = cvt_pk_bf16(silu_f(g1[2]) * u1[2], silu_f(g1[3]) * u1[3]);
                *(u32x4*)(rowp) = w; }
    }
};
struct EpiRes {
    static constexpr bool PERM = false, AFTER_DRAIN = false;
    const float* base; float* out; const float* gate; int gstride;
    __device__ __forceinline__ void operator()(const f32x4 (&acc)[2][2][4][2], const Unit& u, int wr, int wc, int fr, int fq) const {
        const int row0 = u.pm * BM + wr * 64 + fr, col0 = u.pn * BM + wc * 32 + 4 * fq;
        const float* gp = gate + (size_t)(u.pm >> 3) * gstride + col0;
        f32x4 gv[2][2];
#pragma unroll
        for (int bj = 0; bj < 2; ++bj)
#pragma unroll
            for (int n = 0; n < 2; ++n) gv[bj][n] = *(const f32x4*)(gp + bj * HALF + n * 16);
#pragma unroll
        for (int ai = 0; ai < 2; ++ai)
#pragma unroll
            for (int m = 0; m < 4; ++m) { const size_t off = (size_t)(row0 + ai * HALF + m * 16) * 1024 + col0;
#pragma unroll
                for (int bj = 0; bj < 2; ++bj)
#pragma unroll
                    for (int n = 0; n < 2; ++n) { const f32x4 bs = *(const f32x4*)(base + off + bj * HALF + n * 16);
                        *(f32x4*)(out + off + bj * HALF + n * 16) = bs + gv[bj][n] * acc[ai][bj][m][n]; }
                asm volatile("" ::: "memory"); }
    }
};

template <bool BASE_F32> struct EpiResB {
    static constexpr bool PERM = true, AFTER_DRAIN = false;
    const void* base; bf16_t* out; const float* gate; int gstride;
    static __device__ __forceinline__ void unpack(const u32x4 ww, f32x4& lo, f32x4& hi) {
        lo = (f32x4){__builtin_bit_cast(float, ww.x << 16), __builtin_bit_cast(float, ww.x & 0xffff0000u), __builtin_bit_cast(float, ww.y << 16), __builtin_bit_cast(float, ww.y & 0xffff0000u)};
        hi = (f32x4){__builtin_bit_cast(float, ww.z << 16), __builtin_bit_cast(float, ww.z & 0xffff0000u), __builtin_bit_cast(float, ww.w << 16), __builtin_bit_cast(float, ww.w & 0xffff0000u)};
    }
    __device__ __forceinline__ void operator()(const f32x4 (&acc)[2][2][4][2], const Unit& u, int wr, int wc, int fr, int fq) const {
        const int row0 = u.pm * BM + wr * 64 + fr, col0 = u.pn * BM + wc * 32 + 8 * fq;
        bf16_t* op = out + (size_t)row0 * 1024 + col0;
        if (!BASE_F32) {
            const bf16_t* bp = (const bf16_t*)base + (size_t)row0 * 1024 + col0;
            u32x4 w[2][4][2];
#pragma unroll
            for (int ai = 0; ai < 2; ++ai)
#pragma unroll
                for (int m = 0; m < 4; ++m)
#pragma unroll
                    for (int bj = 0; bj < 2; ++bj) w[ai][m][bj] = *(const u32x4*)(bp + (size_t)(ai * HALF + m * 16) * 1024 + bj * HALF);
            const float* gp = gate + (size_t)(u.pm >> 3) * gstride + col0;
            f32x4 gv[2][2];
#pragma unroll
            for (int bj = 0; bj < 2; ++bj)
#pragma unroll
                for (int n = 0; n < 2; ++n) gv[bj][n] = *(const f32x4*)(gp + bj * HALF + 4 * n);
            asm volatile("" ::: "memory");
#pragma unroll
            for (int ai = 0; ai < 2; ++ai)
#pragma unroll
                for (int m = 0; m < 4; ++m)
#pragma unroll
                    for (int bj = 0; bj < 2; ++bj) {
                        f32x4 lo, hi; unpack(w[ai][m][bj], lo, hi);
                        const f32x4 v0 = lo + gv[bj][0] * acc[ai][bj][m][0], v1 = hi + gv[bj][1] * acc[ai][bj][m][1];
                        u32x4 o; o.x = cvt_pk_bf16(v0[0], v0[1]); o.y = cvt_pk_bf16(v0[2], v0[3]); o.z = cvt_pk_bf16(v1[0], v1[1]); o.w = cvt_pk_bf16(v1[2], v1[3]);
                        *(u32x4*)(op + (size_t)(ai * HALF + m * 16) * 1024 + bj * HALF) = o; }
        } else {
            const float* gp = gate + (size_t)(u.pm >> 3) * gstride + col0;
            f32x4 gv[2][2];
#pragma unroll
            for (int bj = 0; bj < 2; ++bj)
#pragma unroll
                for (int n = 0; n < 2; ++n) gv[bj][n] = *(const f32x4*)(gp + bj * HALF + 4 * n);
#pragma unroll
            for (int ai = 0; ai < 2; ++ai) {
                f32x4 b0[4][2], b1[4][2];
#pragma unroll
                for (int m = 0; m < 4; ++m)
#pragma unroll
                    for (int bj = 0; bj < 2; ++bj) { const float* bp = (const float*)base + (size_t)(row0 + ai * HALF + m * 16) * 1024 + col0 + bj * HALF;
                        b0[m][bj] = __builtin_nontemporal_load((const f32x4*)bp); b1[m][bj] = __builtin_nontemporal_load((const f32x4*)(bp + 4)); }
#pragma unroll
                for (int m = 0; m < 4; ++m)
#pragma unroll
                    for (int bj = 0; bj < 2; ++bj) {
                        const f32x4 v0 = b0[m][bj] + gv[bj][0] * acc[ai][bj][m][0], v1 = b1[m][bj] + gv[bj][1] * acc[ai][bj][m][1];
                        u32x4 o; o.x = cvt_pk_bf16(v0[0], v0[1]); o.y = cvt_pk_bf16(v0[2], v0[3]); o.z = cvt_pk_bf16(v1[0], v1[1]); o.w = cvt_pk_bf16(v1[2], v1[3]);
                        *(u32x4*)(op + (size_t)(ai * HALF + m * 16) * 1024 + bj * HALF) = o; }
                asm volatile("" ::: "memory");
            }
        }
    }
};


template <class Epi, class Sched, bool ALIGN_EPI = false, bool SP2 = false>
__device__ __forceinline__ void gemm_phase(PG8_LAS unsigned char* lds, const Gemm g, const Sched& S, const Epi& E) {
    int tid_l = threadIdx.x; asm volatile("" : "+v"(tid_l));
    const int tid = tid_l, wid = __builtin_amdgcn_readfirstlane(tid >> 6), lane = tid & 63, wr = wid >> 2, wc = wid & 3, fr = lane & 15, fq = lane >> 4;
    const int K = g.K, nt = K / BK;
    unsigned voffA[2], voffB[2];
#pragma unroll
    for (int i = 0; i < 2; ++i) { int R, C; stage_rc(tid * 16 + i * 8192, R, C); const int Rb = Epi::PERM ? ((R & ~31) + perm32(R & 31)) : R;
        voffA[i] = (unsigned)(R * K + C) * 2u; voffB[i] = (unsigned)(Rb * K + C) * 2u; }
    const size_t kstep = (size_t)(BK * 2);
    const size_t hstep = (size_t)HALF * K * 2;
    const size_t tstep = 2 * hstep;
    const unsigned ldsw = (unsigned)wid * 1024u;
    const int aoff = lds_byte(wr * 64 + fr, fq * 8), boff = lds_byte(wc * 32 + fr, fq * 8);
#define PG8_SA(b, h) (((b) * 2 + (h)) * HTB)
#define PG8_SB(b, h) ((4 + (b) * 2 + (h)) * HTB)
#define PG8_STAGE(bufoff, gbase, voff) do { _Pragma("unroll") for (int _i = 0; _i < 2; ++_i) \
        __builtin_amdgcn_global_load_lds((const unsigned*)((const char*)(gbase) + (voff)[_i]), (PG8_LAS unsigned*)(lds + (bufoff) + ldsw + _i * 8192), 16, 0, 0); } while (0)
#define PG8_LDA(dst, b, h) do { _Pragma("unroll") for (int m = 0; m < 4; ++m) _Pragma("unroll") for (int k = 0; k < 2; ++k) dst[m][k] = *(const PG8_LAS bf16x8*)(lds + PG8_SA(b, h) + aoff + m * 2048 + k * 1024); } while (0)
#define PG8_LDB(dst, b, h) do { _Pragma("unroll") for (int n = 0; n < 2; ++n) _Pragma("unroll") for (int k = 0; k < 2; ++k) dst[n][k] = *(const PG8_LAS bf16x8*)(lds + PG8_SB(b, h) + boff + n * 2048 + k * 1024); } while (0)
#define PG8_MMA(ai, bj, At, Bt) do { __builtin_amdgcn_s_setprio(1); _Pragma("unroll") for (int m = 0; m < 4; ++m) _Pragma("unroll") for (int n = 0; n < 2; ++n) _Pragma("unroll") for (int k = 0; k < 2; ++k) \
        acc[ai][bj][m][n] = __builtin_amdgcn_mfma_f32_16x16x32_bf16(Bt[n][k], At[m][k], acc[ai][bj][m][n], 0, 0, 0); __builtin_amdgcn_s_setprio(0); } while (0)
#define PG8_WAIT_V(n) asm volatile("s_waitcnt vmcnt(" #n ")" ::: "memory")
#define PG8_WAIT_L(n) asm volatile("s_waitcnt lgkmcnt(" #n ")" ::: "memory")
#define PG8_BAR __builtin_amdgcn_s_barrier()
#define PG8_SCHED __builtin_amdgcn_sched_barrier(0)
    Unit cur, nxt; int ui = 0;
    if (!S.next(0, cur)) return;
    f32x4 acc[2][2][4][2];
#pragma unroll
    for (int a = 0; a < 2; ++a)
#pragma unroll
        for (int b = 0; b < 2; ++b)
#pragma unroll
            for (int m = 0; m < 4; ++m)
#pragma unroll
                for (int n = 0; n < 2; ++n) acc[a][b][m][n] = (f32x4){0.f, 0.f, 0.f, 0.f};
    bf16x8 At[4][2], B0[2][2], B1[2][2];
    const char* cA = (const char*)g.A + (size_t)cur.pm * tstep; const char* cB = (const char*)g.Bt + (size_t)cur.pn * tstep;
    S.a_ready(cur);
    if constexpr (SP2) {
        PG8_STAGE(PG8_SB(0, 0), cB, voffB); PG8_STAGE(PG8_SB(0, 1), cB + hstep, voffB); PG8_STAGE(PG8_SA(0, 0), cA, voffA); PG8_STAGE(PG8_SA(0, 1), cA + hstep, voffA);
        if (wr == 1) PG8_BAR;
        PG8_WAIT_V(2); PG8_BAR;
        PG8_STAGE(PG8_SB(1, 0), cB + kstep, voffB); PG8_STAGE(PG8_SA(1, 0), cA + kstep, voffA); PG8_STAGE(PG8_SB(1, 1), cB + hstep + kstep, voffB);
        PG8_WAIT_V(6); PG8_BAR;
    } else {
        PG8_STAGE(PG8_SB(0, 0), cB, voffB); PG8_STAGE(PG8_SA(0, 0), cA, voffA); PG8_STAGE(PG8_SB(0, 1), cB + hstep, voffB); PG8_STAGE(PG8_SA(0, 1), cA + hstep, voffA);
        if (wr == 1) PG8_BAR;
        PG8_WAIT_V(4); PG8_BAR;
        PG8_STAGE(PG8_SB(1, 0), cB + kstep, voffB); PG8_STAGE(PG8_SA(1, 0), cA + kstep, voffA); PG8_STAGE(PG8_SB(1, 1), cB + hstep + kstep, voffB);
        PG8_WAIT_V(6); PG8_BAR;
    }
    for (;;) {
        const bool has_next = S.next(ui + 1, nxt);
        const char* nA = has_next ? (const char*)g.A + (size_t)nxt.pm * tstep : cA; const char* nB = has_next ? (const char*)g.Bt + (size_t)nxt.pn * tstep : cB;
        for (int t = 0; t < nt; t += 2) {
            const bool last = (t == nt - 2);
            const char* a1 = cA + (size_t)(t + 1) * kstep;
            const char* a2 = last ? nA : cA + (size_t)(t + 2) * kstep; const char* b2 = last ? nB : cB + (size_t)(t + 2) * kstep;
            const char* a3 = a2 + kstep; const char* b3 = b2 + kstep;
            if (last && has_next) S.a_ready(nxt);
            if constexpr (SP2) {
            PG8_LDB(B0, 0, 0); PG8_LDB(B1, 0, 1); PG8_SCHED; PG8_LDA(At, 0, 0); PG8_STAGE(PG8_SA(1, 1), a1 + hstep, voffA);
            PG8_WAIT_V(8); PG8_WAIT_L(0); PG8_BAR; PG8_MMA(0, 0, At, B0); PG8_MMA(0, 1, At, B1); PG8_BAR; PG8_SCHED;
            PG8_LDA(At, 0, 1); PG8_STAGE(PG8_SB(0, 0), b2, voffB); PG8_STAGE(PG8_SB(0, 1), b2 + hstep, voffB); PG8_STAGE(PG8_SA(0, 0), a2, voffA);
            PG8_WAIT_V(8); PG8_WAIT_L(0); PG8_BAR; PG8_MMA(1, 0, At, B0); PG8_MMA(1, 1, At, B1); PG8_BAR; PG8_SCHED;
            PG8_LDB(B0, 1, 0); PG8_LDB(B1, 1, 1); PG8_SCHED; PG8_LDA(At, 1, 0); PG8_STAGE(PG8_SA(0, 1), a2 + hstep, voffA);
            PG8_WAIT_V(8); PG8_WAIT_L(0); PG8_BAR; PG8_MMA(0, 0, At, B0); PG8_MMA(0, 1, At, B1); PG8_BAR; PG8_SCHED;
            PG8_LDA(At, 1, 1); PG8_STAGE(PG8_SB(1, 0), b3, voffB); PG8_STAGE(PG8_SB(1, 1), b3 + hstep, voffB); PG8_STAGE(PG8_SA(1, 0), a3, voffA);
            PG8_WAIT_V(8); PG8_WAIT_L(0); PG8_BAR; PG8_MMA(1, 0, At, B0); PG8_MMA(1, 1, At, B1); PG8_BAR; PG8_SCHED;
            } else {
            PG8_LDB(B0, 0, 0); PG8_SCHED; PG8_LDA(At, 0, 0); PG8_STAGE(PG8_SA(1, 1), a1 + hstep, voffA);
            PG8_WAIT_L(8); PG8_BAR; PG8_WAIT_L(0); PG8_MMA(0, 0, At, B0); PG8_BAR; PG8_SCHED;
            PG8_LDB(B1, 0, 1); PG8_STAGE(PG8_SB(0, 0), b2, voffB);
            PG8_BAR; PG8_WAIT_L(0); PG8_MMA(0, 1, At, B1); PG8_BAR;
            PG8_LDA(At, 0, 1); PG8_STAGE(PG8_SA(0, 0), a2, voffA);
            PG8_BAR; PG8_WAIT_L(0); PG8_MMA(1, 0, At, B0); PG8_BAR; PG8_SCHED;
            PG8_STAGE(PG8_SB(0, 1), b2 + hstep, voffB);
            PG8_WAIT_V(6); PG8_BAR; PG8_MMA(1, 1, At, B1); PG8_BAR;
            PG8_LDB(B0, 1, 0); PG8_SCHED; PG8_LDA(At, 1, 0); PG8_STAGE(PG8_SA(0, 1), a2 + hstep, voffA);
            PG8_WAIT_L(8); PG8_BAR; PG8_WAIT_L(0); PG8_MMA(0, 0, At, B0); PG8_BAR; PG8_SCHED;
            PG8_LDB(B1, 1, 1); PG8_STAGE(PG8_SB(1, 0), b3, voffB);
            PG8_BAR; PG8_WAIT_L(0); PG8_MMA(0, 1, At, B1); PG8_BAR;
            PG8_LDA(At, 1, 1); PG8_STAGE(PG8_SA(1, 0), a3, voffA);
            PG8_BAR; PG8_WAIT_L(0); PG8_MMA(1, 0, At, B0); PG8_BAR; PG8_SCHED;
            PG8_STAGE(PG8_SB(1, 1), b3 + hstep, voffB);
            PG8_WAIT_V(6); PG8_BAR; PG8_MMA(1, 1, At, B1); PG8_BAR;
            }
        }
        if constexpr (ALIGN_EPI) { if (wr == 0) PG8_BAR; }
        if constexpr (!Epi::AFTER_DRAIN) { E(acc, cur, wr, wc, fr, fq); S.done(cur); }
        if (!has_next) break;
#pragma unroll
        for (int a = 0; a < 2; ++a)
#pragma unroll
            for (int b = 0; b < 2; ++b)
#pragma unroll
                for (int m = 0; m < 4; ++m)
#pragma unroll
                    for (int n = 0; n < 2; ++n) acc[a][b][m][n] = (f32x4){0.f, 0.f, 0.f, 0.f};
        cur = nxt; cA = nA; cB = nB; ++ui;
        if constexpr (ALIGN_EPI) { if (wr == 1) PG8_BAR; }
    }
    PG8_WAIT_V(0);
    if constexpr (!ALIGN_EPI) { if (wr == 0) PG8_BAR; }
    PG8_BAR;
    if constexpr (Epi::AFTER_DRAIN) { E.fused(acc, cur, wr, wc, fr, fq, lds, wid, lane); S.done(cur); }
#undef PG8_SA
#undef PG8_SB
#undef PG8_STAGE
#undef PG8_LDA
#undef PG8_LDB
#undef PG8_MMA
#undef PG8_WAIT_V
#undef PG8_WAIT_L
#undef PG8_BAR
#undef PG8_SCHED
}
}

constexpr int DM = 1024, BATCH = 16, SEQ = 2048, M = BATCH * SEQ, DEPTH = 2, NIN = 2560, FF = 2816, NUP = 2 * FF, PROJW = 2048, NMOD = 6 * DM;
constexpr float EPS = 1e-6f;
constexpr int NWAVES = 8, NTHR = 512;
constexpr size_t MiB = 1u << 20;
constexpr size_t WS_WIN = 0, WS_WOUT = 10 * MiB, WS_WUP = 14 * MiB, WS_WDN = 36 * MiB, WS_WSB = 47 * MiB, WS_MOD = 48 * MiB, WS_CTL = 49 * MiB, CTL_BYTES = 16384;
constexpr size_t WS_H = 64 * MiB, WS_PROJ = 128 * MiB, WS_Y = 256 * MiB, WS_ACT = 128 * MiB  , WS_X1 = 320 * MiB, WS_END = 448 * MiB;
static_assert(WS_ACT + (size_t)M * FF * 2 <= WS_X1 && WS_PROJ + (size_t)M * PROJW * 2 <= WS_Y && WS_Y + (size_t)M * DM * 2 <= WS_X1, "ws map");
constexpr int VL_STRIDE = 68, VL_WAVE_BYTES = 128 * VL_STRIDE * 2, SSQV_OFF = 8 * VL_WAVE_BYTES, RSV_OFF = SSQV_OFF + 4096, SSQ2_OFF = RSV_OFF + 512, RSW_OFF = SSQ2_OFF + 4096  , LDS_BYTES = 152 * 1024, MISC_OFF = LDS_BYTES - 64;
static_assert(RSW_OFF + 4096 <= LDS_BYTES - 64, "lds map");

#define LAS __attribute__((address_space(3)))
typedef unsigned short bf16;
typedef unsigned v4u __attribute__((ext_vector_type(4)));
typedef unsigned v2u __attribute__((ext_vector_type(2)));
typedef float f32x4 __attribute__((ext_vector_type(4)));
typedef float f32x16 __attribute__((ext_vector_type(16)));
typedef short bf16x8 __attribute__((ext_vector_type(8)));
#define LDS_WAIT() asm volatile("s_waitcnt lgkmcnt(0)" ::: "memory")
__device__ __forceinline__ unsigned f2bf(float f) { unsigned u = __builtin_bit_cast(unsigned, f); return (u + 0x7fffu + ((u >> 16) & 1u)) >> 16; }
__device__ __forceinline__ unsigned pk2(float lo, float hi) { return f2bf(lo) | (f2bf(hi) << 16); }
__device__ __forceinline__ float bflo(unsigned w) { return __builtin_bit_cast(float, w << 16); }
__device__ __forceinline__ float bfhi(unsigned w) { return __builtin_bit_cast(float, w & 0xffff0000u); }
__device__ __forceinline__ float wave_sum(float v) {
#pragma unroll
    for (int o = 1; o < 64; o <<= 1) v += __shfl_xor(v, o);
    return v;
}

#define XB_TMO      128
#define XB_XCNT(j)  (256  + 64 * (j))
#define XB_XSUB(j)  (1280 + 64 * (j))
#define XB_XGEN(j)  (2304 + 64 * (j))
#define XB_TOP      3328
#define XB_TOPGEN   3392
#define XCD_BAR_WORDS 3456
#define XB_SPIN_CAP (1u << 18)

__device__ __forceinline__ unsigned xb_ld(unsigned* p)              { return __hip_atomic_load(p, __ATOMIC_RELAXED, __HIP_MEMORY_SCOPE_AGENT); }
__device__ __forceinline__ unsigned xb_add(unsigned* p, unsigned v) { return __hip_atomic_fetch_add(p, v, __ATOMIC_RELAXED, __HIP_MEMORY_SCOPE_AGENT); }
__device__ __forceinline__ unsigned xb_xcc_id() { return (unsigned)__builtin_amdgcn_s_getreg((3 << 11) | 20) & 0xFu; }
#define XB_SPIN(cond, bar) do { unsigned _sp = 0; while (cond) { __builtin_amdgcn_s_sleep(1); \
    if ((++_sp & 255u) == 0u) { if (xb_ld(&(bar)[XB_TMO])) break; if (_sp > XB_SPIN_CAP) { atomicAdd(&(bar)[XB_TMO], 1u); break; } } } } while (0)

struct XcdBarrier {
    unsigned* bar; unsigned x;
    volatile LAS unsigned* st;
};

__device__ __forceinline__ XcdBarrier xcd_barrier_post(unsigned* bar, volatile LAS unsigned* st) {
    XcdBarrier b; b.bar = bar; b.x = xb_xcc_id(); b.st = st;
    if (threadIdx.x == 0) st[2] = xb_add(&bar[XB_XCNT(b.x)], 1u);
    return b;
}
__device__ __forceinline__ void xcd_barrier_complete(unsigned* bar, unsigned x, unsigned& nloc, unsigned& nx) {
    const unsigned G = gridDim.x * gridDim.y * gridDim.z;
    unsigned sum, cnt, mine, sp = 0u;
    for (;;) {
        sum = 0u; cnt = 0u; mine = 0u;
#pragma unroll
        for (unsigned j = 0; j < 16; ++j) { const unsigned c = xb_ld(&bar[XB_XCNT(j)]); sum += c; cnt += (c > 0u) ? 1u : 0u; mine = (j == x) ? c : mine; }
        if (sum == G) break;
        __builtin_amdgcn_s_sleep(1);
        if ((++sp & 255u) == 0u) { if (xb_ld(&bar[XB_TMO])) break; if (sp > XB_SPIN_CAP) { atomicAdd(&bar[XB_TMO], 1u); break; } }
    }
    nloc = mine > 0u ? mine : 1u; nx = cnt > 0u ? cnt : 1u;
}

__device__ __forceinline__ void xcd_barrier(const XcdBarrier& b) {
    asm volatile("s_waitcnt vmcnt(0)" ::: "memory");
    __syncthreads();
    if (threadIdx.x == 0) {
        unsigned* bar = b.bar; unsigned bx = b.x; asm volatile("" : "+s"(bar), "+s"(bx));
        __builtin_amdgcn_s_waitcnt(0);
        unsigned nloc = b.st[0], nx = b.st[1];
        if (nloc == 0u) { xcd_barrier_complete(bar, bx, nloc, nx); b.st[0] = nloc; b.st[1] = nx; }
        const unsigned old = xb_add(&bar[XB_XSUB(bx)], 1u);
        const unsigned gen = old / nloc;
        if (old + 1u == (gen + 1u) * nloc) {
            __builtin_amdgcn_fence(__ATOMIC_RELEASE, "agent");
            asm volatile("s_waitcnt vmcnt(0)" ::: "memory");
            const unsigned og = xb_add(&bar[XB_TOP], 1u);
            const unsigned tg = og / nx;
            if (og + 1u == (tg + 1u) * nx) xb_add(&bar[XB_TOPGEN], 1u);
            else XB_SPIN(xb_ld(&bar[XB_TOPGEN]) == tg, bar);
            __builtin_amdgcn_fence(__ATOMIC_ACQUIRE, "agent");
            xb_add(&bar[XB_XGEN(bx)], 1u);
            asm volatile("s_waitcnt vmcnt(0)" ::: "memory");
        } else {
            XB_SPIN(xb_ld(&bar[XB_XGEN(bx)]) == gen, bar);
            __builtin_amdgcn_fence(__ATOMIC_ACQUIRE, "agent");
            asm volatile("s_waitcnt vmcnt(0)" ::: "memory");
        }
    }
    __syncthreads();
}


__device__ __forceinline__ void xcd_barrier_local(const XcdBarrier& b) {
    asm volatile("s_waitcnt vmcnt(0)" ::: "memory");
    __syncthreads();
    if (threadIdx.x == 0) {
        unsigned* bar = b.bar; unsigned bx = b.x; asm volatile("" : "+s"(bar), "+s"(bx));
        __builtin_amdgcn_s_waitcnt(0);
        const unsigned nloc = b.st[0];
        const unsigned old = xb_add(&bar[XB_XSUB(bx)], 1u);
        const unsigned gen = old / nloc;
        if (old + 1u == (gen + 1u) * nloc) xb_add(&bar[XB_XGEN(bx)], 1u);
        else XB_SPIN(xb_ld(&bar[XB_XGEN(bx)]) == gen, bar);
        __builtin_amdgcn_fence(__ATOMIC_ACQUIRE, "agent");
        asm volatile("s_waitcnt vmcnt(0)" ::: "memory");
    }
    __syncthreads();
}

struct Params { const float* in[17]; float* out; unsigned char* ws; int ph_lo, ph_hi; };
enum { I_X = 0, I_C, I_WMOD, I_BMOD, I_NMIX, I_WIN, I_CONVW, I_VNORM, I_WS, I_BS, I_ONA, I_ONB, I_WOUT, I_NFFN, I_WUP, I_WDOWN, I_NFINAL };

template <int MAP> __device__ __forceinline__ int src_col(int r) {
    if (MAP == 1) { if (r < 512 || r >= 1536) return r; const int q = r - 512, j = q >> 8, h = (q >> 7) & 1, i = q & 127; return 512 + h * 512 + 128 * j + i; }
    if (MAP == 2) { const int j = r >> 8, h = (r >> 7) & 1, i = r & 127; return h * FF + 128 * j + i; }
    return r;
}
template <int MAP> __device__ __forceinline__ void transpose_item(const float* W, int K, int N, bf16* WT, LAS float* scr, int item, int lane) {
    const int nblk = N / 32, kb = item / nblk, nb = item % nblk, k0 = 64 * kb, r0 = 32 * nb, n0 = src_col<MAP>(r0);
    float tv[32];
#pragma unroll
    for (int i = 0; i < 32; ++i) tv[i] = __builtin_nontemporal_load(W + (size_t)(k0 + 2 * i + (lane >> 5)) * N + n0 + (lane & 31));
#pragma unroll
    for (int i = 0; i < 32; ++i) scr[(2 * i + (lane >> 5)) * 33 + (lane & 31)] = tv[i];
    LDS_WAIT(); asm volatile("" ::: "memory");
    const int c = lane & 7;
#pragma unroll
    for (int j = 0; j < 4; ++j) { const int n = (lane >> 3) + 8 * j; const LAS float* s = scr + (8 * c) * 33 + n;
        v4u o; o.x = pk2(s[0 * 33], s[1 * 33]); o.y = pk2(s[2 * 33], s[3 * 33]); o.z = pk2(s[4 * 33], s[5 * 33]); o.w = pk2(s[6 * 33], s[7 * 33]);
        *(v4u*)(WT + (size_t)(r0 + n) * K + k0 + 8 * c) = o; }
    LDS_WAIT(); asm volatile("" ::: "memory");
}

__device__ __forceinline__ void norm_phase(const float* X, const float* gamma, const float* modl, int sh_off, int sc_off, bf16* Hout, int lw, int LW, int rbase, int rspan, int lane) {
    constexpr int NR = 2;
    f32x4 g[4];
#pragma unroll
    for (int j = 0; j < 4; ++j) g[j] = ((const f32x4*)gamma)[64 * j + lane];
    for (int u0 = lw * NR; u0 < rspan; u0 += LW * NR) { const int m0 = rbase + u0;
        f32x4 v[NR][4];
#pragma unroll
        for (int r = 0; r < NR; ++r)
#pragma unroll
            for (int j = 0; j < 4; ++j) v[r][j] = __builtin_nontemporal_load((const f32x4*)(X + (size_t)(m0 + r) * DM) + lane + 64 * j);
        const float* mb = modl + (size_t)(m0 >> 11) * NMOD;
        f32x4 sc[4], sh[4];
#pragma unroll
        for (int j = 0; j < 4; ++j) { sc[j] = ((const f32x4*)(mb + sc_off))[64 * j + lane] + 1.0f; sh[j] = ((const f32x4*)(mb + sh_off))[64 * j + lane]; }
#pragma unroll
        for (int r = 0; r < NR; ++r) {
            float s = 0.f;
#pragma unroll
            for (int j = 0; j < 4; ++j) s += (v[r][j].x * v[r][j].x + v[r][j].y * v[r][j].y) + (v[r][j].z * v[r][j].z + v[r][j].w * v[r][j].w);
            const float rs = 1.0f / sqrtf(wave_sum(s) * (1.f / DM) + EPS);
            unsigned long long* o8 = (unsigned long long*)(Hout + (size_t)(m0 + r) * DM) + lane;
#pragma unroll
            for (int j = 0; j < 4; ++j) { const f32x4 o = (v[r][j] * rs) * g[j] * sc[j] + sh[j];
                o8[64 * j] = (unsigned long long)pk2(o.x, o.y) | ((unsigned long long)pk2(o.z, o.w) << 32); }
        }
    }
}

__device__ __forceinline__ void norm_phase_b(const bf16* X, const float* gamma, const float* modl, int sh_off, int sc_off, bf16* Hout, int lw, int LW, int rbase, int rspan, int lane) {
    constexpr int NR = 4;
    f32x4 g[2][2];
#pragma unroll
    for (int j = 0; j < 2; ++j) { g[j][0] = ((const f32x4*)gamma)[2 * (64 * j + lane)]; g[j][1] = ((const f32x4*)gamma)[2 * (64 * j + lane) + 1]; }
    for (int u0 = lw * NR; u0 < rspan; u0 += LW * NR) { const int m0 = rbase + u0;
        v4u w[NR][2];
#pragma unroll
        for (int r = 0; r < NR; ++r)
#pragma unroll
            for (int j = 0; j < 2; ++j) w[r][j] = ((const v4u*)(X + (size_t)(m0 + r) * DM) + lane)[64 * j];
        const float* mb = modl + (size_t)(m0 >> 11) * NMOD;
        f32x4 sc[2][2], sh[2][2];
#pragma unroll
        for (int j = 0; j < 2; ++j)
#pragma unroll
            for (int q = 0; q < 2; ++q) { sc[j][q] = ((const f32x4*)(mb + sc_off))[2 * (64 * j + lane) + q] + 1.0f; sh[j][q] = ((const f32x4*)(mb + sh_off))[2 * (64 * j + lane) + q]; }
#pragma unroll
        for (int r = 0; r < NR; ++r) {
            f32x4 v[2][2]; float s = 0.f;
#pragma unroll
            for (int j = 0; j < 2; ++j) { const v4u ww = w[r][j];
                v[j][0] = (f32x4){bflo(ww.x), bfhi(ww.x), bflo(ww.y), bfhi(ww.y)}; v[j][1] = (f32x4){bflo(ww.z), bfhi(ww.z), bflo(ww.w), bfhi(ww.w)};
#pragma unroll
                for (int q = 0; q < 2; ++q) s += (v[j][q].x * v[j][q].x + v[j][q].y * v[j][q].y) + (v[j][q].z * v[j][q].z + v[j][q].w * v[j][q].w); }
            const float rs = 1.0f / sqrtf(wave_sum(s) * (1.f / DM) + EPS);
            v4u* o16 = (v4u*)(Hout + (size_t)(m0 + r) * DM) + lane;
#pragma unroll
            for (int j = 0; j < 2; ++j) { f32x4 o[2];
#pragma unroll
                for (int q = 0; q < 2; ++q) o[q] = (v[j][q] * rs) * g[j][q] * sc[j][q] + sh[j][q];
                v4u ow; ow.x = pk2(o[0].x, o[0].y); ow.y = pk2(o[0].z, o[0].w); ow.z = pk2(o[1].x, o[1].y); ow.w = pk2(o[1].z, o[1].w);
                o16[64 * j] = ow; }
        }
    }
}

__device__ __forceinline__ void conv_phase(const bf16* PROJ, const float* convw, const float* ga, bf16* Y, int lw, int LW, int rbase, int rspan, int lane) {
    float w0[8], w1[8], w2[8], gg[8];
#pragma unroll
    for (int e = 0; e < 8; ++e) { w0[e] = convw[8 * lane + e]; w1[e] = convw[512 + 8 * lane + e]; w2[e] = convw[1024 + 8 * lane + e]; gg[e] = ga[8 * lane + e]; }
    for (int u0 = lw * 16; u0 < rspan; u0 += LW * 16) {
        const int r0 = rbase + u0;
        float zm1[8], zm2[8];
        if ((r0 & (SEQ - 1)) == 0) {
#pragma unroll
            for (int e = 0; e < 8; ++e) { zm1[e] = 0.f; zm2[e] = 0.f; }
        } else {
            const v4u a = *(const v4u*)(PROJ + (size_t)(r0 - 1) * PROJW + 512 + 8 * lane), b = *(const v4u*)(PROJ + (size_t)(r0 - 2) * PROJW + 512 + 8 * lane);
            zm1[0] = bflo(a.x); zm1[1] = bfhi(a.x); zm1[2] = bflo(a.y); zm1[3] = bfhi(a.y); zm1[4] = bflo(a.z); zm1[5] = bfhi(a.z); zm1[6] = bflo(a.w); zm1[7] = bfhi(a.w);
            zm2[0] = bflo(b.x); zm2[1] = bfhi(b.x); zm2[2] = bflo(b.y); zm2[3] = bfhi(b.y); zm2[4] = bflo(b.z); zm2[5] = bfhi(b.z); zm2[6] = bflo(b.w); zm2[7] = bfhi(b.w);
        }
#pragma unroll 4
        for (int t = 0; t < 16; ++t) {
            const size_t row = (size_t)(r0 + t);
            const v4u zr = *(const v4u*)(PROJ + row * PROJW + 512 + 8 * lane), br = *(const v4u*)(PROJ + row * PROJW + 8 * lane);
            float zc[8], bg[8], ya[8];
            zc[0] = bflo(zr.x); zc[1] = bfhi(zr.x); zc[2] = bflo(zr.y); zc[3] = bfhi(zr.y); zc[4] = bflo(zr.z); zc[5] = bfhi(zr.z); zc[6] = bflo(zr.w); zc[7] = bfhi(zr.w);
            bg[0] = bflo(br.x); bg[1] = bfhi(br.x); bg[2] = bflo(br.y); bg[3] = bfhi(br.y); bg[4] = bflo(br.z); bg[5] = bfhi(br.z); bg[6] = bflo(br.w); bg[7] = bfhi(br.w);
            float s = 0.f;
#pragma unroll
            for (int e = 0; e < 8; ++e) { ya[e] = bg[e] * (w0[e] * zm2[e] + w1[e] * zm1[e] + w2[e] * zc[e]); s += ya[e] * ya[e]; zm2[e] = zm1[e]; zm1[e] = zc[e]; }
            const float rs = 1.0f / sqrtf(wave_sum(s) * (1.f / 512.f) + EPS);
            v4u o; o.x = pk2(ya[0] * rs * gg[0], ya[1] * rs * gg[1]); o.y = pk2(ya[2] * rs * gg[2], ya[3] * rs * gg[3]);
            o.z = pk2(ya[4] * rs * gg[4], ya[5] * rs * gg[5]); o.w = pk2(ya[6] * rs * gg[6], ya[7] * rs * gg[7]);
            *(v4u*)(Y + row * DM + 8 * lane) = o;
        }
    }
}

__device__ __forceinline__ void sgu_phase(LAS unsigned char* lds, const bf16* PROJp, const bf16* Wsb  , const float* vnorm, const float* bs, const float* gb, bf16* Yp,
                                          int item0, int item_stride, int item_end, int tid, int wave, int lane) {
    const int h = wave;
    LAS bf16* VL = (LAS bf16*)(lds + h * VL_WAVE_BYTES);
    LAS float* SSQV = (LAS float*)(lds + SSQV_OFF);
    LAS float* RSV = (LAS float*)(lds + RSV_OFF);
    LAS float* SSQ2 = (LAS float*)(lds + SSQ2_OFF);
    const int r8 = lane >> 3, c8 = lane & 7, il = lane & 31, kg = lane >> 5;
    LAS float* const ssqv_w = SSQV + h * 128 + r8; LAS float* const rsv_r = RSV + r8; LAS bf16* const vl_rc = VL + r8 * VL_STRIDE + 8 * c8;
    LAS bf16* const vl_id = VL + il * VL_STRIDE + 4 * kg; LAS float* const ssq2_w = SSQ2 + h * 128 + il; LAS float* const rsw = (LAS float*)(lds + RSW_OFF) + h * 128;
    const unsigned voff_row = (unsigned)(r8 * PROJW + 8 * c8) * 2u;
    const unsigned voff_gu = (unsigned)(il * PROJW + 4 * kg) * 2u;
    const unsigned voff_w = (unsigned)(il * 128 + 8 * kg) * 2u;
    const unsigned voff_y = (unsigned)(r8 * DM + 8 * c8) * 2u;
    const char* const wbase = (const char*)(Wsb + (size_t)h * 128 * 128);
    const char* const vnb = (const char*)(vnorm + 64 * h);
    int item = item0;
    if (item >= item_end) return;
    for (;;) {
        const size_t t0 = (size_t)item * 128;
        v4u raw[16];
        { const char* vb = (const char*)(PROJp + t0 * PROJW + 1536 + 64 * h); unsigned vr = voff_row; asm volatile("" : "+v"(vr));
#pragma unroll
          for (int it = 0; it < 16; ++it) raw[it] = *(const v4u*)(vb + (size_t)it * (8 * PROJW * 2) + vr); }
#pragma unroll
        for (int it = 0; it < 16; ++it) {
            const v4u a = raw[it];
            float s = (bflo(a.x) * bflo(a.x) + bfhi(a.x) * bfhi(a.x)) + (bflo(a.y) * bflo(a.y) + bfhi(a.y) * bfhi(a.y)) + (bflo(a.z) * bflo(a.z) + bfhi(a.z) * bfhi(a.z)) + (bflo(a.w) * bflo(a.w) + bfhi(a.w) * bfhi(a.w));
            s += __shfl_xor(s, 1); s += __shfl_xor(s, 2); s += __shfl_xor(s, 4);
            if (c8 == 0) ssqv_w[8 * it] = s;
        }
        __syncthreads();
        if (tid < 128) { float s = 0.f;
#pragma unroll
            for (int w = 0; w < 8; ++w) s += SSQV[w * 128 + tid];
            RSV[tid] = 1.0f / sqrtf(s * (1.f / 512.f) + EPS); }
        __syncthreads();
#pragma unroll
        for (int it = 0; it < 16; ++it) {
            const float r = rsv_r[8 * it]; const v4u a = raw[it];
            v2u lo, hi; lo.x = pk2(bflo(a.x) * r, bfhi(a.x) * r); lo.y = pk2(bflo(a.y) * r, bfhi(a.y) * r); hi.x = pk2(bflo(a.z) * r, bfhi(a.z) * r); hi.y = pk2(bflo(a.w) * r, bfhi(a.w) * r);
            *(LAS v2u*)(vl_rc + it * 8 * VL_STRIDE) = lo; *(LAS v2u*)(vl_rc + it * 8 * VL_STRIDE + 4) = hi;
        }
        const int nitem = item + item_stride; const bool has_next = nitem < item_end;
        LDS_WAIT(); asm volatile("" ::: "memory");
        bf16x8 vf[8][2];
#pragma unroll
        for (int ks = 0; ks < 8; ++ks)
#pragma unroll
            for (int nb = 0; nb < 2; ++nb)
#pragma unroll
                for (int e = 0; e < 8; ++e) vf[ks][nb][e] = (short)VL[(16 * ks + 8 * kg + e) * VL_STRIDE + 32 * nb + il];
        LDS_WAIT(); asm volatile("" ::: "memory");
#pragma unroll
        for (int mb = 0; mb < 4; ++mb) {
            const int i = 32 * mb + il;
            const char* gub = (const char*)(PROJp + (t0 + 32 * mb) * PROJW + 1024 + 64 * h); unsigned vg = voff_gu, vw = voff_w, vv = (unsigned)(16 * kg); asm volatile("" : "+v"(vg), "+v"(vw), "+v"(vv));
            v2u gu[2][4];
#pragma unroll
            for (int nb = 0; nb < 2; ++nb)
#pragma unroll
                for (int blk = 0; blk < 4; ++blk) gu[nb][blk] = *(const v2u*)(gub + vg + (32 * nb + 8 * blk) * 2);
            f32x16 acc[2];
#pragma unroll
            for (int nb = 0; nb < 2; ++nb)
#pragma unroll
                for (int r = 0; r < 16; ++r) acc[nb][r] = 0.f;
            const char* wb = wbase + (size_t)(32 * mb) * 128 * 2;
#pragma unroll
            for (int ks = 0; ks < 2 * (mb + 1); ++ks) {
                const bf16x8 wf = *(const bf16x8*)(wb + vw + ks * 32);
                acc[0] = __builtin_amdgcn_mfma_f32_32x32x16_bf16(vf[ks][0], wf, acc[0], 0, 0, 0);
                acc[1] = __builtin_amdgcn_mfma_f32_32x32x16_bf16(vf[ks][1], wf, acc[1], 0, 0, 0);
            }
            const float bsv = bs[h * 128 + i];
            float ss = 0.f;
#pragma unroll
            for (int nb = 0; nb < 2; ++nb)
#pragma unroll
                for (int blk = 0; blk < 4; ++blk) {
                    const f32x4 vn = *(const f32x4*)(vnb + vv + (32 * nb + 8 * blk) * 4);
                    const float y0 = bflo(gu[nb][blk].x) * (acc[nb][4 * blk + 0] * vn.x + bsv), y1 = bfhi(gu[nb][blk].x) * (acc[nb][4 * blk + 1] * vn.y + bsv);
                    const float y2 = bflo(gu[nb][blk].y) * (acc[nb][4 * blk + 2] * vn.z + bsv), y3 = bfhi(gu[nb][blk].y) * (acc[nb][4 * blk + 3] * vn.w + bsv);
                    ss += (y0 * y0 + y1 * y1) + (y2 * y2 + y3 * y3);
                    v2u o; o.x = pk2(y0, y1); o.y = pk2(y2, y3);
                    *(LAS v2u*)(vl_id + 32 * mb * VL_STRIDE + 32 * nb + 8 * blk) = o;
                }
            ss += __shfl_xor(ss, 32);
            if (kg == 0) ssq2_w[32 * mb] = ss;
            asm volatile("" ::: "memory");
        }
        __syncthreads();
        const f32x4 g0 = *(const f32x4*)(gb + 64 * h + 8 * c8), g1 = *(const f32x4*)(gb + 64 * h + 8 * c8 + 4);
        float ta = 0.f, tb = 0.f;
#pragma unroll
        for (int w = 0; w < 8; ++w) { ta += SSQ2[w * 128 + lane]; tb += SSQ2[w * 128 + 64 + lane]; }
        rsw[lane] = 1.0f / sqrtf(ta * (1.f / 512.f) + EPS); rsw[64 + lane] = 1.0f / sqrtf(tb * (1.f / 512.f) + EPS);
        LDS_WAIT(); asm volatile("" ::: "memory");
        char* const yb = (char*)(Yp + t0 * DM + 512 + 64 * h); unsigned vy = voff_y; asm volatile("" : "+v"(vy));
#pragma unroll
        for (int it = 0; it < 16; ++it) {
            const float rs = (rsw + r8)[8 * it];
            const v2u lo = *(const LAS v2u*)(vl_rc + it * 8 * VL_STRIDE), hi = *(const LAS v2u*)(vl_rc + it * 8 * VL_STRIDE + 4);
            v4u o; o.x = pk2(bflo(lo.x) * rs * g0.x, bfhi(lo.x) * rs * g0.y); o.y = pk2(bflo(lo.y) * rs * g0.z, bfhi(lo.y) * rs * g0.w);
            o.z = pk2(bflo(hi.x) * rs * g1.x, bfhi(hi.x) * rs * g1.y); o.w = pk2(bflo(hi.y) * rs * g1.z, bfhi(hi.y) * rs * g1.w);
            *(v4u*)(yb + (size_t)it * (8 * DM * 2) + vy) = o;
            if ((it & 3) == 3) asm volatile("" ::: "memory");
        }
        if (!has_next) break;
        item = nitem;
    }
}

constexpr int NPHASE = 16;
__global__ void __launch_bounds__(NTHR, 2) fwd_megakernel(Params p) {
    extern __shared__ __attribute__((aligned(16))) unsigned char lds_raw[];
    LAS unsigned char* lds = (LAS unsigned char*)lds_raw;
    const int G = gridDim.x, NGW = G * NWAVES;
#define LANE_IDS() int tid_l = threadIdx.x; asm volatile("" : "+v"(tid_l)); const int tid = tid_l, lane = tid & 63, wave = __builtin_amdgcn_readfirstlane(tid >> 6), gw = blockIdx.x * NWAVES + wave; (void)lane; (void)gw; (void)tid; KARG_BASE()
    typedef const __attribute__((address_space(4))) unsigned long long* kargp_t;
#define KARG_BASE() kargp_t ka_ = (kargp_t)__builtin_amdgcn_kernarg_segment_ptr(); asm volatile("" : "+s"(ka_)); unsigned char* const ws = (unsigned char*)ka_[18]; (void)ws
#define PIN(i) ((const float*)ka_[i])
#define POUT ((float*)ka_[17])
#define MOD ((float*)(ws + WS_MOD))
#define H ((bf16*)(ws + WS_H))
#define PROJ ((bf16*)(ws + WS_PROJ))
#define Y ((bf16*)(ws + WS_Y))
#define ACT ((bf16*)(ws + WS_ACT))
#define X1 ((bf16*)(ws + WS_X1))
#ifdef DIAG_ONLY
#define IN(k) (((k) == DIAG_ONLY))
#else
#define IN(k) (true)
#endif
    if (threadIdx.x < 16) ((LAS unsigned*)(lds + MISC_OFF))[threadIdx.x] = 0u;
    __syncthreads();
    XcdBarrier bar; { KARG_BASE(); bar = xcd_barrier_post((unsigned*)(ws + WS_CTL), (volatile LAS unsigned*)(lds + MISC_OFF)); }
#ifndef PROBE_MASK
#define PROBE_MASK 0
#endif
#define REPS(k) for (int rep_ = 0; rep_ <= ((PROBE_MASK >> (k)) & 1); ++rep_)
#define REP_BAR() do { if (rep_) xcd_barrier(bar); } while (0)
#define SEAM(k) do { if (IN(k) && IN((k) + 1)) xcd_barrier(bar); } while (0)

    if (IN(0)) REPS(0) {
        REP_BAR();
        LANE_IDS();
        LAS float* scr = (LAS float*)(lds + wave * 16384);
        constexpr int I_IN = 16 * (NIN / 32), I_OUT = 16 * (DM / 32), I_UP = 16 * (NUP / 32), I_DN = (FF / 64) * (DM / 32), I_L = I_IN + I_OUT + I_UP + I_DN;
        for (int it = gw; it < DEPTH * I_L; it += NGW) {
            const int l = it / I_L; int r = it % I_L;
            if (r < I_IN) { transpose_item<1>(PIN(I_WIN) + (size_t)l * DM * NIN, DM, NIN, (bf16*)(ws + WS_WIN) + (size_t)l * NIN * DM, scr, r, lane); continue; } r -= I_IN;
            if (r < I_OUT) { transpose_item<0>(PIN(I_WOUT) + (size_t)l * DM * DM, DM, DM, (bf16*)(ws + WS_WOUT) + (size_t)l * DM * DM, scr, r, lane); continue; } r -= I_OUT;
            if (r < I_UP) { transpose_item<2>(PIN(I_WUP) + (size_t)l * DM * NUP, DM, NUP, (bf16*)(ws + WS_WUP) + (size_t)l * NUP * DM, scr, r, lane); continue; } r -= I_UP;
            transpose_item<0>(PIN(I_WDOWN) + (size_t)l * FF * DM, FF, DM, (bf16*)(ws + WS_WDN) + (size_t)l * DM * FF, scr, r, lane);
        }
        { bf16* Wsb = (bf16*)(ws + WS_WSB); const float* wsrc = PIN(I_WS);
          for (int e = blockIdx.x * NTHR + tid; e < DEPTH * 8 * 128 * 128; e += G * NTHR) { const int j = e & 127, i = (e >> 7) & 127; Wsb[e] = (bf16)(j <= i ? f2bf(wsrc[e]) : 0u); } }
        __syncthreads();
        for (int item = blockIdx.x; item < DEPTH * (NMOD / 64); item += G) {
            const int l = item / (NMOD / 64), col0 = (item % (NMOD / 64)) * 64;
            LAS float* cact = (LAS float*)lds;
            LAS float* red = (LAS float*)(lds + 65536);
            for (int idx = tid; idx < BATCH * DM; idx += NTHR) { const int b = idx >> 10, k = idx & 1023; const float cv = PIN(I_C)[idx]; cact[k * 16 + b] = cv / (1.0f + expf(-cv)); }
            __syncthreads();
            float a[16];
#pragma unroll
            for (int b = 0; b < 16; ++b) a[b] = 0.f;
            const float* wp = PIN(I_WMOD) + (size_t)l * DM * NMOD + (size_t)(wave * 128) * NMOD + col0 + lane;
            for (int k0 = 0; k0 < 128; k0 += 32) {
            float wv32[32];
#pragma unroll
            for (int kk = 0; kk < 32; ++kk) wv32[kk] = __builtin_nontemporal_load(wp + (size_t)(k0 + kk) * NMOD);
#pragma unroll
            for (int kk = 0; kk < 32; ++kk) { const int k = k0 + kk;
                const float wv = wv32[kk];
                const LAS f32x4* cr = (const LAS f32x4*)(cact + (wave * 128 + k) * 16);
                const f32x4 c0 = cr[0], c1 = cr[1], c2 = cr[2], c3 = cr[3];
                a[0] += c0.x * wv; a[1] += c0.y * wv; a[2] += c0.z * wv; a[3] += c0.w * wv; a[4] += c1.x * wv; a[5] += c1.y * wv; a[6] += c1.z * wv; a[7] += c1.w * wv;
                a[8] += c2.x * wv; a[9] += c2.y * wv; a[10] += c2.z * wv; a[11] += c2.w * wv; a[12] += c3.x * wv; a[13] += c3.y * wv; a[14] += c3.z * wv; a[15] += c3.w * wv;
            }
            }
#pragma unroll
            for (int b = 0; b < 16; ++b) red[(wave * 16 + b) * 64 + lane] = a[b];
            __syncthreads();
            for (int o = tid; o < 16 * 64; o += NTHR) { const int b = o >> 6, cc = o & 63; float s = PIN(I_BMOD)[l * NMOD + col0 + cc];
#pragma unroll
                for (int w = 0; w < 8; ++w) s += red[(w * 16 + b) * 64 + cc];
                MOD[((size_t)l * BATCH + b) * NMOD + col0 + cc] = s; }
            __syncthreads();
        }
    }
    xcd_barrier(bar);
    const unsigned cx_ = bar.x, cn_ = ((volatile LAS unsigned*)(lds + MISC_OFF))[0], cnx_ = ((volatile LAS unsigned*)(lds + MISC_OFF))[1], cr_ = ((volatile LAS unsigned*)(lds + MISC_OFF))[2];
    bool xlocal = (G == 256) && (cn_ == 32u) && (cnx_ == 8u) && (cx_ < 8u) && (cr_ < 32u);
    { KARG_BASE(); unsigned* cw = (unsigned*)(ws + WS_CTL);
#pragma unroll
      for (int j = 0; j < 8; ++j) xlocal = xlocal && (__builtin_amdgcn_readfirstlane((int)xb_ld(&cw[XB_XCNT(j)])) == 32); }
    const int vblk = xlocal ? (int)(cr_ * 8u + cx_) : (int)blockIdx.x;
    const int rbase = xlocal ? (int)cx_ * (M / 8) : 0, rspan = xlocal ? M / 8 : M;
    const int lblk = xlocal ? (int)cr_ : (int)blockIdx.x, LWAVES = xlocal ? 32 * NWAVES : NGW;
#undef SEAM
#define SEAM(k) do { if (xlocal) xcd_barrier_local(bar); else xcd_barrier(bar); } while (0)

#ifndef PROBE_LAYER
#define PROBE_LAYER 0
#endif
    for (int li = 0; li < DEPTH + PROBE_LAYER; ++li) {
        const int l = (li <= PROBE_LAYER) ? 0 : li - PROBE_LAYER;
        const int P = 1 + 7 * l;
#define modl (MOD + (size_t)l * BATCH * NMOD)
        if (IN(P + 0)) REPS(P + 0) { REP_BAR(); LANE_IDS(); if (l == 0) norm_phase(PIN(I_X), PIN(I_NMIX) + l * DM, modl, 0 * DM, 1 * DM, H, lblk * NWAVES + wave, LWAVES, rbase, rspan, lane); else norm_phase_b(X1, PIN(I_NMIX) + l * DM, modl, 0 * DM, 1 * DM, H, lblk * NWAVES + wave, LWAVES, rbase, rspan, lane); }
        SEAM(P + 0);
        if (IN(P + 1)) REPS(P + 1) {
            REP_BAR();
            KARG_BASE();
            pg8::Gemm g{H, (const bf16*)(ws + WS_WIN) + (size_t)l * NIN * DM, M, NIN, DM}; pg8::StaticOrder S; S.init(M, NIN, G, vblk);
            pg8::EpiProj E{PROJ};
            pg8::gemm_phase<pg8::EpiProj, pg8::StaticOrder, true, true>(lds, g, S, E);
        }
        SEAM(P + 1);
        if (IN(P + 2)) REPS(P + 2) {
            REP_BAR();
            LANE_IDS();
            sgu_phase(lds, PROJ, (const bf16*)(ws + WS_WSB) + (size_t)l * 8 * 128 * 128, PIN(I_VNORM) + l * 512, PIN(I_BS) + l * 8 * 128, PIN(I_ONB) + l * 512, Y, rbase / 128 + lblk, LWAVES / NWAVES, (rbase + rspan) / 128, tid, wave, lane);
            conv_phase(PROJ, PIN(I_CONVW) + l * 3 * 512, PIN(I_ONA) + l * 512, Y, lblk * NWAVES + wave, LWAVES, rbase, rspan, lane);
        }
        SEAM(P + 2);
        if (IN(P + 3)) REPS(P + 3) {
            REP_BAR();
            KARG_BASE();
            pg8::Gemm g{Y, (const bf16*)(ws + WS_WOUT) + (size_t)l * DM * DM, M, DM, DM}; pg8::StaticOrder S; S.init(M, DM, G, vblk);
            if (l == 0) { pg8::EpiResB<true> E{PIN(I_X), X1, modl + 2 * DM, NMOD}; pg8::gemm_phase<pg8::EpiResB<true>, pg8::StaticOrder, true, true>(lds, g, S, E); }
            else { pg8::EpiResB<false> E{X1, X1, modl + 2 * DM, NMOD}; pg8::gemm_phase<pg8::EpiResB<false>, pg8::StaticOrder, true, true>(lds, g, S, E); }
        }
        SEAM(P + 3);
        if (IN(P + 4)) REPS(P + 4) { REP_BAR(); LANE_IDS(); norm_phase_b(X1, PIN(I_NFFN) + l * DM, modl, 3 * DM, 4 * DM, H, lblk * NWAVES + wave, LWAVES, rbase, rspan, lane); }
        SEAM(P + 4);
        if (IN(P + 5)) REPS(P + 5) {
            REP_BAR();
            KARG_BASE();
            pg8::Gemm g{H, (const bf16*)(ws + WS_WUP) + (size_t)l * NUP * DM, M, NUP, DM}; pg8::StaticOrder S; S.init(M, NUP, G, vblk);
            pg8::EpiSwiGLU E{ACT, FF};
            pg8::gemm_phase<pg8::EpiSwiGLU, pg8::StaticOrder, true, true>(lds, g, S, E);
        }
        SEAM(P + 5);
        if (IN(P + 6)) REPS(P + 6) {
            REP_BAR();
            KARG_BASE();
            pg8::Gemm g{ACT, (const bf16*)(ws + WS_WDN) + (size_t)l * DM * FF, M, DM, FF}; pg8::StaticOrder S; S.init(M, DM, G, vblk);
            pg8::EpiResB<false> E{X1, X1, modl + 5 * DM, NMOD};
            pg8::gemm_phase<pg8::EpiResB<false>, pg8::StaticOrder, true, true>(lds, g, S, E);
        }
        SEAM(P + 6);
    }
    if (IN(15)) {
        LANE_IDS();
        constexpr int NR = 4;
        f32x4 g[2][2];
#pragma unroll
        for (int j = 0; j < 2; ++j) { g[j][0] = ((const f32x4*)PIN(I_NFINAL))[2 * (64 * j + lane)]; g[j][1] = ((const f32x4*)PIN(I_NFINAL))[2 * (64 * j + lane) + 1]; }
        const int lw = lblk * NWAVES + wave, LW = LWAVES;
        for (int u0 = lw * NR; u0 < rspan; u0 += LW * NR) { const int m0 = rbase + u0;
            v4u w[NR][2];
#pragma unroll
            for (int r = 0; r < NR; ++r)
#pragma unroll
                for (int j = 0; j < 2; ++j) w[r][j] = ((const v4u*)(X1 + (size_t)(m0 + r) * DM) + lane)[64 * j];
#pragma unroll
            for (int r = 0; r < NR; ++r) {
                f32x4 v[2][2]; float s = 0.f;
#pragma unroll
                for (int j = 0; j < 2; ++j) { const v4u ww = w[r][j];
                    v[j][0] = (f32x4){bflo(ww.x), bfhi(ww.x), bflo(ww.y), bfhi(ww.y)}; v[j][1] = (f32x4){bflo(ww.z), bfhi(ww.z), bflo(ww.w), bfhi(ww.w)};
#pragma unroll
                    for (int q = 0; q < 2; ++q) s += (v[j][q].x * v[j][q].x + v[j][q].y * v[j][q].y) + (v[j][q].z * v[j][q].z + v[j][q].w * v[j][q].w); }
                const float rs = 1.0f / sqrtf(wave_sum(s) * (1.f / DM) + EPS);
                f32x4* orow = (f32x4*)(POUT + (size_t)(m0 + r) * DM);
#pragma unroll
                for (int j = 0; j < 2; ++j)
#pragma unroll
                    for (int q = 0; q < 2; ++q) __builtin_nontemporal_store((v[j][q] * rs) * g[j][q], orow + 2 * (64 * j + lane) + q);
            }
        }
    }
#undef IN
#undef SEAM
}

#undef MOD
#undef H
#undef PROJ
#undef Y
#undef ACT
#undef X1
#undef modl
#undef xin
extern "C" void kernel_launch(void* const* d_in, const int* in_sizes, int n_in, void* d_out, int out_size, void* d_ws, size_t ws_size, hipStream_t stream) {
    static int grid = 0;
    if (grid == 0) {
        if (n_in != 17 || in_sizes[0] != M * DM || out_size != M * DM || ws_size < WS_END) { fprintf(stderr, "kernel_launch: unexpected shapes (n_in %d, in0 %d, out %d, ws %zu); nothing launched\n", n_in, n_in > 0 ? in_sizes[0] : -1, out_size, ws_size); grid = -1; return; }
        int dev = 0, cus = 0, per_cu = 0;
        hipGetDevice(&dev); hipDeviceGetAttribute(&cus, hipDeviceAttributeMultiprocessorCount, dev);
        if (hipFuncSetAttribute((const void*)fwd_megakernel, hipFuncAttributeMaxDynamicSharedMemorySize, LDS_BYTES) != hipSuccess) { fprintf(stderr, "kernel_launch: hipFuncSetAttribute failed\n"); grid = -1; return; }
        if (hipOccupancyMaxActiveBlocksPerMultiprocessor(&per_cu, (const void*)fwd_megakernel, NTHR, LDS_BYTES) != hipSuccess || per_cu < 1) { fprintf(stderr, "kernel_launch: occupancy query says %d blocks per CU; nothing launched\n", per_cu); (void)hipGetLastError(); grid = -1; return; }
        grid = cus * (per_cu > 1 ? 1 : per_cu);
    }
    if (grid < 0) return;
    if (hipMemsetAsync((char*)d_ws + WS_CTL, 0, CTL_BYTES, stream) != hipSuccess) { fprintf(stderr, "kernel_launch: hipMemsetAsync failed\n"); return; }
    Params p{};
    for (int i = 0; i < 17; ++i) p.in[i] = (const float*)d_in[i];
    p.out = (float*)d_out; p.ws = (unsigned char*)d_ws;
    p.ph_lo = 0; p.ph_hi = NPHASE;
    void* args[] = {&p};
    hipError_t e = hipLaunchCooperativeKernel((const void*)fwd_megakernel, dim3(grid), dim3(NTHR), args, LDS_BYTES, stream);
    if (e != hipSuccess) fprintf(stderr, "cooperative launch failed: %s (grid %d)\n", hipGetErrorString(e), grid);
}
```

```cpp
#include <hip/hip_runtime.h>
#include <hip/hip_cooperative_groups.h>
#include <cstdio>
#include <cstdint>
namespace cg = cooperative_groups;
#define MK_PER_PHASE 0
#define PROBE_MASK 0
#define PROBE_LAYER 0
namespace pg8 {
#define PG8_LAS __attribute__((address_space(3)))
typedef unsigned short bf16_t;
typedef short bf16x8 __attribute__((ext_vector_type(8)));
typedef float f32x4 __attribute__((ext_vector_type(4)));
typedef unsigned u32x4 __attribute__((ext_vector_type(4)));
constexpr int BM = 256, BK = 64, HALF = 128, HTB = HALF * BK * 2  , STAGE_BYTES = 8 * HTB, NXCD = 8, WGM = 4;

__host__ __device__ __forceinline__ int lds_byte(int r, int c) { const int st = (r >> 4) * 2 + (c >> 5), rr = r & 15, cc = c & 31, ob = rr * 64 + cc * 2; return st * 1024 + (ob ^ (((ob >> 9) & 1) << 5)); }
__host__ __device__ __forceinline__ void stage_rc(int b, int& R, int& C) { const int st = b / 1024, sb = b % 1024, swz = sb ^ (((sb >> 9) & 1) << 5); R = (st >> 1) * 16 + swz / 64; C = (st & 1) * 32 + (swz % 64) / 2; }
__host__ __device__ __forceinline__ int perm32(int rho) { const int n = rho >> 4, i = rho & 15; return 8 * (i >> 2) + 4 * n + (i & 3); }

struct Unit { int pm, pn; };
struct Gemm { const bf16_t* A; const bf16_t* Bt; int M, N, K; };

struct StaticOrder {
    int nM, nN, nwg, G, c;
    __host__ __device__ void init(int M, int N, int G_, int c_) { nM = M / BM; nN = N / BM; nwg = nM * nN; G = G_; c = c_; }
    __host__ __device__ bool next(int i, Unit& u) const {
        const long L = (long)i * G + c; if (L >= nwg) return false;
        int wgid = (int)L; { const int q = nwg / NXCD, r = nwg % NXCD, xcd = wgid % NXCD, off = wgid / NXCD; wgid = (xcd < r ? xcd * (q + 1) : r * (q + 1) + (xcd - r) * q) + off; }
        const int nig = WGM * nN, gid = wgid / nig, fm = gid * WGM, gsz = (nM - fm) < WGM ? (nM - fm) : WGM;
        u.pm = fm + ((wgid % nig) % gsz); u.pn = (wgid % nig) / gsz; return true;
    }
    __device__ __forceinline__ void a_ready(const Unit&) const {}
    __device__ __forceinline__ void done(const Unit&) const {}
};


__device__ __forceinline__ unsigned cvt_pk_bf16(float lo, float hi) { unsigned r; asm volatile("v_cvt_pk_bf16_f32 %0, %1, %2" : "=v"(r) : "v"(lo), "v"(hi)); return r; }
__device__ __forceinline__ float gelu_t(float x) {
    const float u2 = x * (1.5957691216f + 0.0713548163f * x * x);
    const float e = __builtin_amdgcn_exp2f(-1.4426950409f * u2);
    return x * __builtin_amdgcn_rcpf(1.0f + e);
}
__device__ __forceinline__ float silu_f(float x) {
    const float e = __builtin_amdgcn_exp2f(-1.4426950409f * x);
    return x * __builtin_amdgcn_rcpf(1.0f + e);
}
struct EpiProj {
    static constexpr bool PERM = true, AFTER_DRAIN = false;
    bf16_t* O;
    __device__ __forceinline__ void operator()(const f32x4 (&acc)[2][2][4][2], const Unit& u, int wr, int wc, int fr, int fq) const {
        const int row0 = u.pm * BM + wr * 64 + fr; const int pn = u.pn;
        if (pn < 2) {
            const int col0 = 256 * pn + wc * 32 + 8 * fq;
#pragma unroll
            for (int ai = 0; ai < 2; ++ai)
#pragma unroll
                for (int m = 0; m < 4; ++m) { bf16_t* rowp = O + (size_t)(row0 + ai * HALF + m * 16) * 2048 + col0;
#pragma unroll
                    for (int bj = 0; bj < 2; ++bj) { const f32x4 v0 = acc[ai][bj][m][0], v1 = acc[ai][bj][m][1];
                        u32x4 w; w.x = cvt_pk_bf16(v0[0], v0[1]); w.y = cvt_pk_bf16(v0[2], v0[3]); w.z = cvt_pk_bf16(v1[0], v1[1]); w.w = cvt_pk_bf16(v1[2], v1[3]);
                        *(u32x4*)(rowp + bj * HALF) = w; } }
        } else if (pn < 6) {
            const int col0 = 512 + 128 * (pn - 2) + wc * 32 + 8 * fq;
#pragma unroll
            for (int ai = 0; ai < 2; ++ai)
#pragma unroll
                for (int m = 0; m < 4; ++m) { bf16_t* rowp = O + (size_t)(row0 + ai * HALF + m * 16) * 2048 + col0;
                    const f32x4 v0 = acc[ai][0][m][0] * acc[ai][1][m][0], v1 = acc[ai][0][m][1] * acc[ai][1][m][1];
                    u32x4 w; w.x = cvt_pk_bf16(v0[0], v0[1]); w.y = cvt_pk_bf16(v0[2], v0[3]); w.z = cvt_pk_bf16(v1[0], v1[1]); w.w = cvt_pk_bf16(v1[2], v1[3]);
                    *(u32x4*)(rowp) = w; }
        } else {
            const int col0 = 1024 + 256 * (pn - 6) + wc * 32 + 8 * fq;
#pragma unroll
            for (int ai = 0; ai < 2; ++ai)
#pragma unroll
                for (int m = 0; m < 4; ++m) { bf16_t* rowp = O + (size_t)(row0 + ai * HALF + m * 16) * 2048 + col0;
#pragma unroll
                    for (int bj = 0; bj < 2; ++bj) { const f32x4 v0 = acc[ai][bj][m][0], v1 = acc[ai][bj][m][1];
                        u32x4 w; w.x = cvt_pk_bf16(gelu_t(v0[0]), gelu_t(v0[1])); w.y = cvt_pk_bf16(gelu_t(v0[2]), gelu_t(v0[3]));
                        w.z = cvt_pk_bf16(gelu_t(v1[0]), gelu_t(v1[1])); w.w = cvt_pk_bf16(gelu_t(v1[2]), gelu_t(v1[3]));
                        *(u32x4*)(rowp + bj * HALF) = w; } }
        }
    }
};
struct EpiSwiGLU {
    static constexpr bool PERM = true, AFTER_DRAIN = false;
    bf16_t* O; int ldc;
    __device__ __forceinline__ void operator()(const f32x4 (&acc)[2][2][4][2], const Unit& u, int wr, int wc, int fr, int fq) const {
        const int row0 = u.pm * BM + wr * 64 + fr; const int col0 = 128 * u.pn + wc * 32 + 8 * fq;
#pragma unroll
        for (int ai = 0; ai < 2; ++ai)
#pragma unroll
            for (int m = 0; m < 4; ++m) { bf16_t* rowp = O + (size_t)(row0 + ai * HALF + m * 16) * ldc + col0;
                const f32x4 g0 = acc[ai][0][m][0], g1 = acc[ai][0][m][1], u0 = acc[ai][1][m][0], u1 = acc[ai][1][m][1];
                u32x4 w; w.x = cvt_pk_bf16(silu_f(g0[0]) * u0[0], silu_f(g0[1]) * u0[1]); w.y = cvt_pk_bf16(silu_f(g0[2]) * u0[2], silu_f(g0[3]) * u0[3]);
                w.z = cvt_pk_bf16(silu_f(g1[0]) * u1[0], silu_f(g1[1]) * u1[1]); w.w = cvt_pk_bf16(silu_f(g1[2]) * u1[2], silu_f(g1[3]) * u1[3]);
                *(u32x4*)(rowp) = w; }
    }
};
struct EpiRes {
    static constexpr bool PERM = false, AFTER_DRAIN = false;
    const float* base; float* out; const float* gate; int gstride;
    __device__ __forceinline__ void operator()(const f32x4 (&acc)[2][2][4][2], const Unit& u, int wr, int wc, int fr, int fq) const {
        const int row0 = u.pm * BM + wr * 64 + fr, col0 = u.pn * BM + wc * 32 + 4 * fq;
        const float* gp = gate + (size_t)(u.pm >> 3) * gstride + col0;
        f32x4 gv[2][2];
#pragma unroll
        for (int bj = 0; bj < 2; ++bj)
#pragma unroll
            for (int n = 0; n < 2; ++n) gv[bj][n] = *(const f32x4*)(gp + bj * HALF + n * 16);
#pragma unroll
        for (int ai = 0; ai < 2; ++ai)
#pragma unroll
            for (int m = 0; m < 4; ++m) { const size_t off = (size_t)(row0 + ai * HALF + m * 16) * 1024 + col0;
#pragma unroll
                for (int bj = 0; bj < 2; ++bj)
#pragma unroll
                    for (int n = 0; n < 2; ++n) { const f32x4 bs = *(const f32x4*)(base + off + bj * HALF + n * 16);
                        *(f32x4*)(out + off + bj * HALF + n * 16) = bs + gv[bj][n] * acc[ai][bj][m][n]; }
                asm volatile("" ::: "memory"); }
    }
};

template <bool BASE_F32> struct EpiResB {
    static constexpr bool PERM = true, AFTER_DRAIN = false;
    const void* base; bf16_t* out; const float* gate; int gstride;
    static __device__ __forceinline__ void unpack(const u32x4 ww, f32x4& lo, f32x4& hi) {
        lo = (f32x4){__builtin_bit_cast(float, ww.x << 16), __builtin_bit_cast(float, ww.x & 0xffff0000u), __builtin_bit_cast(float, ww.y << 16), __builtin_bit_cast(float, ww.y & 0xffff0000u)};
        hi = (f32x4){__builtin_bit_cast(float, ww.z << 16), __builtin_bit_cast(float, ww.z & 0xffff0000u), __builtin_bit_cast(float, ww.w << 16), __builtin_bit_cast(float, ww.w & 0xffff0000u)};
    }
    __device__ __forceinline__ void operator()(const f32x4 (&acc)[2][2][4][2], const Unit& u, int wr, int wc, int fr, int fq) const {
        const int row0 = u.pm * BM + wr * 64 + fr, col0 = u.pn * BM + wc * 32 + 8 * fq;
        bf16_t* op = out + (size_t)row0 * 1024 + col0;
        if (!BASE_F32) {
            const bf16_t* bp = (const bf16_t*)base + (size_t)row0 * 1024 + col0;
            u32x4 w[2][4][2];
#pragma unroll
            for (int ai = 0; ai < 2; ++ai)
#pragma unroll
                for (int m = 0; m < 4; ++m)
#pragma unroll
                    for (int bj = 0; bj < 2; ++bj) w[ai][m][bj] = *(const u32x4*)(bp + (size_t)(ai * HALF + m * 16) * 1024 + bj * HALF);
            const float* gp = gate + (size_t)(u.pm >> 3) * gstride + col0;
            f32x4 gv[2][2];
#pragma unroll
            for (int bj = 0; bj < 2; ++bj)
#pragma unroll
                for (int n = 0; n < 2; ++n) gv[bj][n] = *(const f32x4*)(gp + bj * HALF + 4 * n);
            asm volatile("" ::: "memory");
#pragma unroll
            for (int ai = 0; ai < 2; ++ai)
#pragma unroll
                for (int m = 0; m < 4; ++m)
#pragma unroll
                    for (int bj = 0; bj < 2; ++bj) {
                        f32x4 lo, hi; unpack(w[ai][m][bj], lo, hi);
                        const f32x4 v0 = lo + gv[bj][0] * acc[ai][bj][m][0], v1 = hi + gv[bj][1] * acc[ai][bj][m][1];
                        u32x4 o; o.x = cvt_pk_bf16(v0[0], v0[1]); o.y = cvt_pk_bf16(v0[2], v0[3]); o.z = cvt_pk_bf16(v1[0], v1[1]); o.w = cvt_pk_bf16(v1[2], v1[3]);
                        *(u32x4*)(op + (size_t)(ai * HALF + m * 16) * 1024 + bj * HALF) = o; }
        } else {
            const float* gp = gate + (size_t)(u.pm >> 3) * gstride + col0;
            f32x4 gv[2][2];
#pragma unroll
            for (int bj = 0; bj < 2; ++bj)
#pragma unroll
                for (int n = 0; n < 2; ++n) gv[bj][n] = *(const f32x4*)(gp + bj * HALF + 4 * n);
#pragma unroll
            for (int ai = 0; ai < 2; ++ai) {
                f32x4 b0[4][2], b1[4][2];
#pragma unroll
                for (int m = 0; m < 4; ++m)
#pragma unroll
                    for (int bj = 0; bj < 2; ++bj) { const float* bp = (const float*)base + (size_t)(row0 + ai * HALF + m * 16) * 1024 + col0 + bj * HALF;
                        b0[m][bj] = __builtin_nontemporal_load((const f32x4*)bp); b1[m][bj] = __builtin_nontemporal_load((const f32x4*)(bp + 4)); }
#pragma unroll
                for (int m = 0; m < 4; ++m)
#pragma unroll
                    for (int bj = 0; bj < 2; ++bj) {
                        const f32x4 v0 = b0[m][bj] + gv[bj][0] * acc[ai][bj][m][0], v1 = b1[m][bj] + gv[bj][1] * acc[ai][bj][m][1];
                        u32x4 o; o.x = cvt_pk_bf16(v0[0], v0[1]); o.y = cvt_pk_bf16(v0[2], v0[3]); o.z = cvt_pk_bf16(v1[0], v1[1]); o.w = cvt_pk_bf16(v1[2], v1[3]);
                        *(u32x4*)(op + (size_t)(ai * HALF + m * 16) * 1024 + bj * HALF) = o; }
                asm volatile("" ::: "memory");
            }
        }
    }
};


template <class Epi, class Sched, bool ALIGN_EPI = false, bool SP2 = false>
__device__ __forceinline__ void gemm_phase(PG8_LAS unsigned char* lds, const Gemm g, const Sched& S, const Epi& E) {
    int tid_l = threadIdx.x; asm volatile("" : "+v"(tid_l));
    const int tid = tid_l, wid = __builtin_amdgcn_readfirstlane(tid >> 6), lane = tid & 63, wr = wid >> 2, wc = wid & 3, fr = lane & 15, fq = lane >> 4;
    const int K = g.K, nt = K / BK;
    unsigned voffA[2], voffB[2];
#pragma unroll
    for (int i = 0; i < 2; ++i) { int R, C; stage_rc(tid * 16 + i * 8192, R, C); const int Rb = Epi::PERM ? ((R & ~31) + perm32(R & 31)) : R;
        voffA[i] = (unsigned)(R * K + C) * 2u; voffB[i] = (unsigned)(Rb * K + C) * 2u; }
    const size_t kstep = (size_t)(BK * 2);
    const size_t hstep = (size_t)HALF * K * 2;
    const size_t tstep = 2 * hstep;
    const unsigned ldsw = (unsigned)wid * 1024u;
    const int aoff = lds_byte(wr * 64 + fr, fq * 8), boff = lds_byte(wc * 32 + fr, fq * 8);
#define PG8_SA(b, h) (((b) * 2 + (h)) * HTB)
#define PG8_SB(b, h) ((4 + (b) * 2 + (h)) * HTB)
#define PG8_STAGE(bufoff, gbase, voff) do { _Pragma("unroll") for (int _i = 0; _i < 2; ++_i) \
        __builtin_amdgcn_global_load_lds((const unsigned*)((const char*)(gbase) + (voff)[_i]), (PG8_LAS unsigned*)(lds + (bufoff) + ldsw + _i * 8192), 16, 0, 0); } while (0)
#define PG8_LDA(dst, b, h) do { _Pragma("unroll") for (int m = 0; m < 4; ++m) _Pragma("unroll") for (int k = 0; k < 2; ++k) dst[m][k] = *(const PG8_LAS bf16x8*)(lds + PG8_SA(b, h) + aoff + m * 2048 + k * 1024); } while (0)
#define PG8_LDB(dst, b, h) do { _Pragma("unroll") for (int n = 0; n < 2; ++n) _Pragma("unroll") for (int k = 0; k < 2; ++k) dst[n][k] = *(const PG8_LAS bf16x8*)(lds + PG8_SB(b, h) + boff + n * 2048 + k * 1024); } while (0)
#define PG8_MMA(ai, bj, At, Bt) do { __builtin_amdgcn_s_setprio(1); _Pragma("unroll") for (int m = 0; m < 4; ++m) _Pragma("unroll") for (int n = 0; n < 2; ++n) _Pragma("unroll") for (int k = 0; k < 2; ++k) \
        acc[ai][bj][m][n] = __builtin_amdgcn_mfma_f32_16x16x32_bf16(Bt[n][k], At[m][k], acc[ai][bj][m][n], 0, 0, 0); __builtin_amdgcn_s_setprio(0); } while (0)
#define PG8_WAIT_V(n) asm volatile("s_waitcnt vmcnt(" #n ")" ::: "memory")
#define PG8_WAIT_L(n) asm volatile("s_waitcnt lgkmcnt(" #n ")" ::: "memory")
#define PG8_BAR __builtin_amdgcn_s_barrier()
#define PG8_SCHED __builtin_amdgcn_sched_barrier(0)
    Unit cur, nxt; int ui = 0;
    if (!S.next(0, cur)) return;
    f32x4 acc[2][2][4][2];
#pragma unroll
    for (int a = 0; a < 2; ++a)
#pragma unroll
        for (int b = 0; b < 2; ++b)
#pragma unroll
            for (int m = 0; m < 4; ++m)
#pragma unroll
                for (int n = 0; n < 2; ++n) acc[a][b][m][n] = (f32x4){0.f, 0.f, 0.f, 0.f};
    bf16x8 At[4][2], B0[2][2], B1[2][2];
    const char* cA = (const char*)g.A + (size_t)cur.pm * tstep; const char* cB = (const char*)g.Bt + (size_t)cur.pn * tstep;
    S.a_ready(cur);
    if constexpr (SP2) {
        PG8_STAGE(PG8_SB(0, 0), cB, voffB); PG8_STAGE(PG8_SB(0, 1), cB + hstep, voffB); PG8_STAGE(PG8_SA(0, 0), cA, voffA); PG8_STAGE(PG8_SA(0, 1), cA + hstep, voffA);
        if (wr == 1) PG8_BAR;
        PG8_WAIT_V(2); PG8_BAR;
        PG8_STAGE(PG8_SB(1, 0), cB + kstep, voffB); PG8_STAGE(PG8_SA(1, 0), cA + kstep, voffA); PG8_STAGE(PG8_SB(1, 1), cB + hstep + kstep, voffB);
        PG8_WAIT_V(6); PG8_BAR;
    } else {
        PG8_STAGE(PG8_SB(0, 0), cB, voffB); PG8_STAGE(PG8_SA(0, 0), cA, voffA); PG8_STAGE(PG8_SB(0, 1), cB + hstep, voffB); PG8_STAGE(PG8_SA(0, 1), cA + hstep, voffA);
        if (wr == 1) PG8_BAR;
        PG8_WAIT_V(4); PG8_BAR;
        PG8_STAGE(PG8_SB(1, 0), cB + kstep, voffB); PG8_STAGE(PG8_SA(1, 0), cA + kstep, voffA); PG8_STAGE(PG8_SB(1, 1), cB + hstep + kstep, voffB);
        PG8_WAIT_V(6); PG8_BAR;
    }
    for (;;) {
        const bool has_next = S.next(ui + 1, nxt);
        const char* nA = has_next ? (const char*)g.A + (size_t)nxt.pm * tstep : cA; const char* nB = has_next ? (const char*)g.Bt + (size_t)nxt.pn * tstep : cB;
        for (int t = 0; t < nt; t += 2) {
            const bool last = (t == nt - 2);
            const char* a1 = cA + (size_t)(t + 1) * kstep;
            const char* a2 = last ? nA : cA + (size_t)(t + 2) * kstep; const char* b2 = last ? nB : cB + (size_t)(t + 2) * kstep;
            const char* a3 = a2 + kstep; const char* b3 = b2 + kstep;
            if (last && has_next) S.a_ready(nxt);
            if constexpr (SP2) {
            PG8_LDB(B0, 0, 0); PG8_LDB(B1, 0, 1); PG8_SCHED; PG8_LDA(At, 0, 0); PG8_STAGE(PG8_SA(1, 1), a1 + hstep, voffA);
            PG8_WAIT_V(8); PG8_WAIT_L(0); PG8_BAR; PG8_MMA(0, 0, At, B0); PG8_MMA(0, 1, At, B1); PG8_BAR; PG8_SCHED;
            PG8_LDA(At, 0, 1); PG8_STAGE(PG8_SB(0, 0), b2, voffB); PG8_STAGE(PG8_SB(0, 1), b2 + hstep, voffB); PG8_STAGE(PG8_SA(0, 0), a2, voffA);
            PG8_WAIT_V(8); PG8_WAIT_L(0); PG8_BAR; PG8_MMA(1, 0, At, B0); PG8_MMA(1, 1, At, B1); PG8_BAR; PG8_SCHED;
            PG8_LDB(B0, 1, 0); PG8_LDB(B1, 1, 1); PG8_SCHED; PG8_LDA(At, 1, 0); PG8_STAGE(PG8_SA(0, 1), a2 + hstep, voffA);
            PG8_WAIT_V(8); PG8_WAIT_L(0); PG8_BAR; PG8_MMA(0, 0, At, B0); PG8_MMA(0, 1, At, B1); PG8_BAR; PG8_SCHED;
            PG8_LDA(At, 1, 1); PG8_STAGE(PG8_SB(1, 0), b3, voffB); PG8_STAGE(PG8_SB(1, 1), b3 + hstep, voffB); PG8_STAGE(PG8_SA(1, 0), a3, voffA);
            PG8_WAIT_V(8); PG8_WAIT_L(0); PG8_BAR; PG8_MMA(1, 0, At, B0); PG8_MMA(1, 1, At, B1); PG8_BAR; PG8_SCHED;
            } else {
            PG8_LDB(B0, 0, 0); PG8_SCHED; PG8_LDA(At, 0, 0); PG8_STAGE(PG8_SA(1, 1), a1 + hstep, voffA);
            PG8_WAIT_L(8); PG8_BAR; PG8_WAIT_L(0); PG8_MMA(0, 0, At, B0); PG8_BAR; PG8_SCHED;
            PG8_LDB(B1, 0, 1); PG8_STAGE(PG8_SB(0, 0), b2, voffB);
            PG8_BAR; PG8_WAIT_L(0); PG8_MMA(0, 1, At, B1); PG8_BAR;
            PG8_LDA(At, 0, 1); PG8_STAGE(PG8_SA(0, 0), a2, voffA);
            PG8_BAR; PG8_WAIT_L(0); PG8_MMA(1, 0, At, B0); PG8_BAR; PG8_SCHED;
            PG8_STAGE(PG8_SB(0, 1), b2 + hstep, voffB);
            PG8_WAIT_V(6); PG8_BAR; PG8_MMA(1, 1, At, B1); PG8_BAR;
            PG8_LDB(B0, 1, 0); PG8_SCHED; PG8_LDA(At, 1, 0); PG8_STAGE(PG8_SA(0, 1), a2 + hstep, voffA);
            PG8_WAIT_L(8); PG8_BAR; PG8_WAIT_L(0); PG8_MMA(0, 0, At, B0); PG8_BAR; PG8_SCHED;
            PG8_LDB(B1, 1, 1); PG8_STAGE(PG8_SB(1, 0), b3, voffB);
            PG8_BAR; PG8_WAIT_L(0); PG8_MMA(0, 1, At, B1); PG8_BAR;
            PG8_LDA(At, 1, 1); PG8_STAGE(PG8_SA(1, 0), a3, voffA);
            PG8_BAR; PG8_WAIT_L(0); PG8_MMA(1, 0, At, B0); PG8_BAR; PG8_SCHED;
            PG8_STAGE(PG8_SB(1, 1), b3 + hstep, voffB);
            PG8_WAIT_V(6); PG8_BAR; PG8_MMA(1, 1, At, B1); PG8_BAR;
            }
        }
        if constexpr (ALIGN_EPI) { if (wr == 0) PG8_BAR; }
        if constexpr (!Epi::AFTER_DRAIN) { E(acc, cur, wr, wc, fr, fq); S.done(cur); }
        if (!has_next) break;
#pragma unroll
        for (int a = 0; a < 2; ++a)
#pragma unroll
            for (int b = 0; b < 2; ++b)
#pragma unroll
                for (int m = 0; m < 4; ++m)
#pragma unroll
                    for (int n = 0; n < 2; ++n) acc[a][b][m][n] = (f32x4){0.f, 0.f, 0.f, 0.f};
        cur = nxt; cA = nA; cB = nB; ++ui;
        if constexpr (ALIGN_EPI) { if (wr == 1) PG8_BAR; }
    }
    PG8_WAIT_V(0);
    if constexpr (!ALIGN_EPI) { if (wr == 0) PG8_BAR; }
    PG8_BAR;
    if constexpr (Epi::AFTER_DRAIN) { E.fused(acc, cur, wr, wc, fr, fq, lds, wid, lane); S.done(cur); }
#undef PG8_SA
#undef PG8_SB
#undef PG8_STAGE
#undef PG8_LDA
#undef PG8_LDB
#undef PG8_MMA
#undef PG8_WAIT_V
#undef PG8_WAIT_L
#undef PG8_BAR
#undef PG8_SCHED
}
}

constexpr int DM = 1024, BATCH = 16, SEQ = 2048, M = BATCH * SEQ, DEPTH = 2, NIN = 2560, FF = 2816, NUP = 2 * FF, PROJW = 2048, NMOD = 6 * DM;
constexpr float EPS = 1e-6f;
constexpr int NWAVES = 8, NTHR = 512;
constexpr size_t MiB = 1u << 20;
constexpr size_t WS_WIN = 0, WS_WOUT = 10 * MiB, WS_WUP = 14 * MiB, WS_WDN = 36 * MiB, WS_WSB = 47 * MiB, WS_MOD = 48 * MiB, WS_CTL = 49 * MiB, CTL_BYTES = 16384;
constexpr size_t WS_H = 64 * MiB, WS_PROJ = 128 * MiB, WS_Y = 256 * MiB, WS_ACT = 128 * MiB  , WS_X1 = 320 * MiB, WS_END = 448 * MiB;
static_assert(WS_ACT + (size_t)M * FF * 2 <= WS_X1 && WS_PROJ + (size_t)M * PROJW * 2 <= WS_Y && WS_Y + (size_t)M * DM * 2 <= WS_X1, "ws map");
constexpr int VL_STRIDE = 68, VL_WAVE_BYTES = 128 * VL_STRIDE * 2, SSQV_OFF = 8 * VL_WAVE_BYTES, RSV_OFF = SSQV_OFF + 4096, SSQ2_OFF = RSV_OFF + 512, RSW_OFF = SSQ2_OFF + 4096  , LDS_BYTES = 152 * 1024, MISC_OFF = LDS_BYTES - 64;
static_assert(RSW_OFF + 4096 <= LDS_BYTES - 64, "lds map");

#define LAS __attribute__((address_space(3)))
typedef unsigned short bf16;
typedef unsigned v4u __attribute__((ext_vector_type(4)));
typedef unsigned v2u __attribute__((ext_vector_type(2)));
typedef float f32x4 __attribute__((ext_vector_type(4)));
typedef float f32x16 __attribute__((ext_vector_type(16)));
typedef short bf16x8 __attribute__((ext_vector_type(8)));
#define LDS_WAIT() asm volatile("s_waitcnt lgkmcnt(0)" ::: "memory")
__device__ __forceinline__ unsigned f2bf(float f) { unsigned u = __builtin_bit_cast(unsigned, f); return (u + 0x7fffu + ((u >> 16) & 1u)) >> 16; }
__device__ __forceinline__ unsigned pk2(float lo, float hi) { return f2bf(lo) | (f2bf(hi) << 16); }
__device__ __forceinline__ float bflo(unsigned w) { return __builtin_bit_cast(float, w << 16); }
__device__ __forceinline__ float bfhi(unsigned w) { return __builtin_bit_cast(float, w & 0xffff0000u); }
__device__ __forceinline__ float wave_sum(float v) {
#pragma unroll
    for (int o = 1; o < 64; o <<= 1) v += __shfl_xor(v, o);
    return v;
}

#define XB_TMO      128
#define XB_XCNT(j)  (256  + 64 * (j))
#define XB_XSUB(j)  (1280 + 64 * (j))
#define XB_XGEN(j)  (2304 + 64 * (j))
#define XB_TOP      3328
#define XB_TOPGEN   3392
#define XCD_BAR_WORDS 3456
#define XB_SPIN_CAP (1u << 18)

__device__ __forceinline__ unsigned xb_ld(unsigned* p)              { return __hip_atomic_load(p, __ATOMIC_RELAXED, __HIP_MEMORY_SCOPE_AGENT); }
__device__ __forceinline__ unsigned xb_add(unsigned* p, unsigned v) { return __hip_atomic_fetch_add(p, v, __ATOMIC_RELAXED, __HIP_MEMORY_SCOPE_AGENT); }
__device__ __forceinline__ unsigned xb_xcc_id() { return (unsigned)__builtin_amdgcn_s_getreg((3 << 11) | 20) & 0xFu; }
#define XB_SPIN(cond, bar) do { unsigned _sp = 0; while (cond) { __builtin_amdgcn_s_sleep(1); \
    if ((++_sp & 255u) == 0u) { if (xb_ld(&(bar)[XB_TMO])) break; if (_sp > XB_SPIN_CAP) { atomicAdd(&(bar)[XB_TMO], 1u); break; } } } } while (0)

struct XcdBarrier {
    unsigned* bar; unsigned x;
    volatile LAS unsigned* st;
};

__device__ __forceinline__ XcdBarrier xcd_barrier_post(unsigned* bar, volatile LAS unsigned* st) {
    XcdBarrier b; b.bar = bar; b.x = xb_xcc_id(); b.st = st;
    if (threadIdx.x == 0) st[2] = xb_add(&bar[XB_XCNT(b.x)], 1u);
    return b;
}
__device__ __forceinline__ void xcd_barrier_complete(unsigned* bar, unsigned x, unsigned& nloc, unsigned& nx) {
    const unsigned G = gridDim.x * gridDim.y * gridDim.z;
    unsigned sum, cnt, mine, sp = 0u;
    for (;;) {
        sum = 0u; cnt = 0u; mine = 0u;
#pragma unroll
        for (unsigned j = 0; j < 16; ++j) { const unsigned c = xb_ld(&bar[XB_XCNT(j)]); sum += c; cnt += (c > 0u) ? 1u : 0u; mine = (j == x) ? c : mine; }
        if (sum == G) break;
        __builtin_amdgcn_s_sleep(1);
        if ((++sp & 255u) == 0u) { if (xb_ld(&bar[XB_TMO])) break; if (sp > XB_SPIN_CAP) { atomicAdd(&bar[XB_TMO], 1u); break; } }
    }
    nloc = mine > 0u ? mine : 1u; nx = cnt > 0u ? cnt : 1u;
}

__device__ __forceinline__ void xcd_barrier(const XcdBarrier& b) {
    asm volatile("s_waitcnt vmcnt(0)" ::: "memory");
    __syncthreads();
    if (threadIdx.x == 0) {
        unsigned* bar = b.bar; unsigned bx = b.x; asm volatile("" : "+s"(bar), "+s"(bx));
        __builtin_amdgcn_s_waitcnt(0);
        unsigned nloc = b.st[0], nx = b.st[1];
        if (nloc == 0u) { xcd_barrier_complete(bar, bx, nloc, nx); b.st[0] = nloc; b.st[1] = nx; }
        const unsigned old = xb_add(&bar[XB_XSUB(bx)], 1u);
        const unsigned gen = old / nloc;
        if (old + 1u == (gen + 1u) * nloc) {
            __builtin_amdgcn_fence(__ATOMIC_RELEASE, "agent");
            asm volatile("s_waitcnt vmcnt(0)" ::: "memory");
            const unsigned og = xb_add(&bar[XB_TOP], 1u);
            const unsigned tg = og / nx;
            if (og + 1u == (tg + 1u) * nx) xb_add(&bar[XB_TOPGEN], 1u);
            else XB_SPIN(xb_ld(&bar[XB_TOPGEN]) == tg, bar);
            __builtin_amdgcn_fence(__ATOMIC_ACQUIRE, "agent");
            xb_add(&bar[XB_XGEN(bx)], 1u);
            asm volatile("s_waitcnt vmcnt(0)" ::: "memory");
        } else {
            XB_SPIN(xb_ld(&bar[XB_XGEN(bx)]) == gen, bar);
            __builtin_amdgcn_fence(__ATOMIC_ACQUIRE, "agent");
            asm volatile("s_waitcnt vmcnt(0)" ::: "memory");
        }
    }
    __syncthreads();
}


__device__ __forceinline__ void xcd_barrier_local(const XcdBarrier& b) {
    asm volatile("s_waitcnt vmcnt(0)" ::: "memory");
    __syncthreads();
    if (threadIdx.x == 0) {
        unsigned* bar = b.bar; unsigned bx = b.x; asm volatile("" : "+s"(bar), "+s"(bx));
        __builtin_amdgcn_s_waitcnt(0);
        const unsigned nloc = b.st[0];
        const unsigned old = xb_add(&bar[XB_XSUB(bx)], 1u);
        const unsigned gen = old / nloc;
        if (old + 1u == (gen + 1u) * nloc) xb_add(&bar[XB_XGEN(bx)], 1u);
        else XB_SPIN(xb_ld(&bar[XB_XGEN(bx)]) == gen, bar);
        __builtin_amdgcn_fence(__ATOMIC_ACQUIRE, "agent");
        asm volatile("s_waitcnt vmcnt(0)" ::: "memory");
    }
    __syncthreads();
}

struct Params { const float* in[17]; float* out; unsigned char* ws; int ph_lo, ph_hi; };
enum { I_X = 0, I_C, I_WMOD, I_BMOD, I_NMIX, I_WIN, I_CONVW, I_VNORM, I_WS, I_BS, I_ONA, I_ONB, I_WOUT, I_NFFN, I_WUP, I_WDOWN, I_NFINAL };

template <int MAP> __device__ __forceinline__ int src_col(int r) {
    if (MAP == 1) { if (r < 512 || r >= 1536) return r; const int q = r - 512, j = q >> 8, h = (q >> 7) & 1, i = q & 127; return 512 + h * 512 + 128 * j + i; }
    if (MAP == 2) { const int j = r >> 8, h = (r >> 7) & 1, i = r & 127; return h * FF + 128 * j + i; }
    return r;
}
template <int MAP> __device__ __forceinline__ void transpose_item(const float* W, int K, int N, bf16* WT, LAS float* scr, int item, int lane) {
    const int nblk = N / 32, kb = item / nblk, nb = item % nblk, k0 = 64 * kb, r0 = 32 * nb, n0 = src_col<MAP>(r0);
    float tv[32];
#pragma unroll
    for (int i = 0; i < 32; ++i) tv[i] = __builtin_nontemporal_load(W + (size_t)(k0 + 2 * i + (lane >> 5)) * N + n0 + (lane & 31));
#pragma unroll
    for (int i = 0; i < 32; ++i) scr[(2 * i + (lane >> 5)) * 33 + (lane & 31)] = tv[i];
    LDS_WAIT(); asm volatile("" ::: "memory");
    const int c = lane & 7;
#pragma unroll
    for (int j = 0; j < 4; ++j) { const int n = (lane >> 3) + 8 * j; const LAS float* s = scr + (8 * c) * 33 + n;
        v4u o; o.x = pk2(s[0 * 33], s[1 * 33]); o.y = pk2(s[2 * 33], s[3 * 33]); o.z = pk2(s[4 * 33], s[5 * 33]); o.w = pk2(s[6 * 33], s[7 * 33]);
        *(v4u*)(WT + (size_t)(r0 + n) * K + k0 + 8 * c) = o; }
    LDS_WAIT(); asm volatile("" ::: "memory");
}

__device__ __forceinline__ void norm_phase(const float* X, const float* gamma, const float* modl, int sh_off, int sc_off, bf16* Hout, int lw, int LW, int rbase, int rspan, int lane) {
    constexpr int NR = 2;
    f32x4 g[4];
#pragma unroll
    for (int j = 0; j < 4; ++j) g[j] = ((const f32x4*)gamma)[64 * j + lane];
    for (int u0 = lw * NR; u0 < rspan; u0 += LW * NR) { const int m0 = rbase + u0;
        f32x4 v[NR][4];
#pragma unroll
        for (int r = 0; r < NR; ++r)
#pragma unroll
            for (int j = 0; j < 4; ++j) v[r][j] = __builtin_nontemporal_load((const f32x4*)(X + (size_t)(m0 + r) * DM) + lane + 64 * j);
        const float* mb = modl + (size_t)(m0 >> 11) * NMOD;
        f32x4 sc[4], sh[4];
#pragma unroll
        for (int j = 0; j < 4; ++j) { sc[j] = ((const f32x4*)(mb + sc_off))[64 * j + lane] + 1.0f; sh[j] = ((const f32x4*)(mb + sh_off))[64 * j + lane]; }
#pragma unroll
        for (int r = 0; r < NR; ++r) {
            float s = 0.f;
#pragma unroll
            for (int j = 0; j < 4; ++j) s += (v[r][j].x * v[r][j].x + v[r][j].y * v[r][j].y) + (v[r][j].z * v[r][j].z + v[r][j].w * v[r][j].w);
            const float rs = 1.0f / sqrtf(wave_sum(s) * (1.f / DM) + EPS);
            unsigned long long* o8 = (unsigned long long*)(Hout + (size_t)(m0 + r) * DM) + lane;
#pragma unroll
            for (int j = 0; j < 4; ++j) { const f32x4 o = (v[r][j] * rs) * g[j] * sc[j] + sh[j];
                o8[64 * j] = (unsigned long long)pk2(o.x, o.y) | ((unsigned long long)pk2(o.z, o.w) << 32); }
        }
    }
}

__device__ __forceinline__ void norm_phase_b(const bf16* X, const float* gamma, const float* modl, int sh_off, int sc_off, bf16* Hout, int lw, int LW, int rbase, int rspan, int lane) {
    constexpr int NR = 4;
    f32x4 g[2][2];
#pragma unroll
    for (int j = 0; j < 2; ++j) { g[j][0] = ((const f32x4*)gamma)[2 * (64 * j + lane)]; g[j][1] = ((const f32x4*)gamma)[2 * (64 * j + lane) + 1]; }
    for (int u0 = lw * NR; u0 < rspan; u0 += LW * NR) { const int m0 = rbase + u0;
        v4u w[NR][2];
#pragma unroll
        for (int r = 0; r < NR; ++r)
#pragma unroll
            for (int j = 0; j < 2; ++j) w[r][j] = ((const v4u*)(X + (size_t)(m0 + r) * DM) + lane)[64 * j];
        const float* mb = modl + (size_t)(m0 >> 11) * NMOD;
        f32x4 sc[2][2], sh[2][2];
#pragma unroll
        for (int j = 0; j < 2; ++j)
#pragma unroll
            for (int q = 0; q < 2; ++q) { sc[j][q] = ((const f32x4*)(mb + sc_off))[2 * (64 * j + lane) + q] + 1.0f; sh[j][q] = ((const f32x4*)(mb + sh_off))[2 * (64 * j + lane) + q]; }
#pragma unroll
        for (int r = 0; r < NR; ++r) {
            f32x4 v[2][2]; float s = 0.f;
#pragma unroll
            for (int j = 0; j < 2; ++j) { const v4u ww = w[r][j];
                v[j][0] = (f32x4){bflo(ww.x), bfhi(ww.x), bflo(ww.y), bfhi(ww.y)}; v[j][1] = (f32x4){bflo(ww.z), bfhi(ww.z), bflo(ww.w), bfhi(ww.w)};
#pragma unroll
                for (int q = 0; q < 2; ++q) s += (v[j][q].x * v[j][q].x + v[j][q].y * v[j][q].y) + (v[j][q].z * v[j][q].z + v[j][q].w * v[j][q].w); }
            const float rs = 1.0f / sqrtf(wave_sum(s) * (1.f / DM) + EPS);
            v4u* o16 = (v4u*)(Hout + (size_t)(m0 + r) * DM) + lane;
#pragma unroll
            for (int j = 0; j < 2; ++j) { f32x4 o[2];
#pragma unroll
                for (int q = 0; q < 2; ++q) o[q] = (v[j][q] * rs) * g[j][q] * sc[j][q] + sh[j][q];
                v4u ow; ow.x = pk2(o[0].x, o[0].y); ow.y = pk2(o[0].z, o[0].w); ow.z = pk2(o[1].x, o[1].y); ow.w = pk2(o[1].z, o[1].w);
                o16[64 * j] = ow; }
        }
    }
}

__device__ __forceinline__ void conv_phase(const bf16* PROJ, const float* convw, const float* ga, bf16* Y, int lw, int LW, int rbase, int rspan, int lane) {
    float w0[8], w1[8], w2[8], gg[8];
#pragma unroll
    for (int e = 0; e < 8; ++e) { w0[e] = convw[8 * lane + e]; w1[e] = convw[512 + 8 * lane + e]; w2[e] = convw[1024 + 8 * lane + e]; gg[e] = ga[8 * lane + e]; }
    for (int u0 = lw * 16; u0 < rspan; u0 += LW * 16) {
        const int r0 = rbase + u0;
        float zm1[8], zm2[8];
        if ((r0 & (SEQ - 1)) == 0) {
#pragma unroll
            for (int e = 0; e < 8; ++e) { zm1[e] = 0.f; zm2[e] = 0.f; }
        } else {
            const v4u a = *(const v4u*)(PROJ + (size_t)(r0 - 1) * PROJW + 512 + 8 * lane), b = *(const v4u*)(PROJ + (size_t)(r0 - 2) * PROJW + 512 + 8 * lane);
            zm1[0] = bflo(a.x); zm1[1] = bfhi(a.x); zm1[2] = bflo(a.y); zm1[3] = bfhi(a.y); zm1[4] = bflo(a.z); zm1[5] = bfhi(a.z); zm1[6] = bflo(a.w); zm1[7] = bfhi(a.w);
            zm2[0] = bflo(b.x); zm2[1] = bfhi(b.x); zm2[2] = bflo(b.y); zm2[3] = bfhi(b.y); zm2[4] = bflo(b.z); zm2[5] = bfhi(b.z); zm2[6] = bflo(b.w); zm2[7] = bfhi(b.w);
        }
#pragma unroll 4
        for (int t = 0; t < 16; ++t) {
            const size_t row = (size_t)(r0 + t);
            const v4u zr = *(const v4u*)(PROJ + row * PROJW + 512 + 8 * lane), br = *(const v4u*)(PROJ + row * PROJW + 8 * lane);
            float zc[8], bg[8], ya[8];
            zc[0] = bflo(zr.x); zc[1] = bfhi(zr.x); zc[2] = bflo(zr.y); zc[3] = bfhi(zr.y); zc[4] = bflo(zr.z); zc[5] = bfhi(zr.z); zc[6] = bflo(zr.w); zc[7] = bfhi(zr.w);
            bg[0] = bflo(br.x); bg[1] = bfhi(br.x); bg[2] = bflo(br.y); bg[3] = bfhi(br.y); bg[4] = bflo(br.z); bg[5] = bfhi(br.z); bg[6] = bflo(br.w); bg[7] = bfhi(br.w);
            float s = 0.f;
#pragma unroll
            for (int e = 0; e < 8; ++e) { ya[e] = bg[e] * (w0[e] * zm2[e] + w1[e] * zm1[e] + w2[e] * zc[e]); s += ya[e] * ya[e]; zm2[e] = zm1[e]; zm1[e] = zc[e]; }
            const float rs = 1.0f / sqrtf(wave_sum(s) * (1.f / 512.f) + EPS);
            v4u o; o.x = pk2(ya[0] * rs * gg[0], ya[1] * rs * gg[1]); o.y = pk2(ya[2] * rs * gg[2], ya[3] * rs * gg[3]);
            o.z = pk2(ya[4] * rs * gg[4], ya[5] * rs * gg[5]); o.w = pk2(ya[6] * rs * gg[6], ya[7] * rs * gg[7]);
            *(v4u*)(Y + row * DM + 8 * lane) = o;
        }
    }
}

__device__ __forceinline__ void sgu_phase(LAS unsigned char* lds, const bf16* PROJp, const bf16* Wsb  , const float* vnorm, const float* bs, const float* gb, bf16* Yp,
                                          int item0, int item_stride, int item_end, int tid, int wave, int lane) {
    const int h = wave;
    LAS bf16* VL = (LAS bf16*)(lds + h * VL_WAVE_BYTES);
    LAS float* SSQV = (LAS float*)(lds + SSQV_OFF);
    LAS float* RSV = (LAS float*)(lds + RSV_OFF);
    LAS float* SSQ2 = (LAS float*)(lds + SSQ2_OFF);
    const int r8 = lane >> 3, c8 = lane & 7, il = lane & 31, kg = lane >> 5;
    LAS float* const ssqv_w = SSQV + h * 128 + r8; LAS float* const rsv_r = RSV + r8; LAS bf16* const vl_rc = VL + r8 * VL_STRIDE + 8 * c8;
    LAS bf16* const vl_id = VL + il * VL_STRIDE + 4 * kg; LAS float* const ssq2_w = SSQ2 + h * 128 + il; LAS float* const rsw = (LAS float*)(lds + RSW_OFF) + h * 128;
    const unsigned voff_row = (unsigned)(r8 * PROJW + 8 * c8) * 2u;
    const unsigned voff_gu = (unsigned)(il * PROJW + 4 * kg) * 2u;
    const unsigned voff_w = (unsigned)(il * 128 + 8 * kg) * 2u;
    const unsigned voff_y = (unsigned)(r8 * DM + 8 * c8) * 2u;
    const char* const wbase = (const char*)(Wsb + (size_t)h * 128 * 128);
    const char* const vnb = (const char*)(vnorm + 64 * h);
    int item = item0;
    if (item >= item_end) return;
    for (;;) {
        const size_t t0 = (size_t)item * 128;
        v4u raw[16];
        { const char* vb = (const char*)(PROJp + t0 * PROJW + 1536 + 64 * h); unsigned vr = voff_row; asm volatile("" : "+v"(vr));
#pragma unroll
          for (int it = 0; it < 16; ++it) raw[it] = *(const v4u*)(vb + (size_t)it * (8 * PROJW * 2) + vr); }
#pragma unroll
        for (int it = 0; it < 16; ++it) {
            const v4u a = raw[it];
            float s = (bflo(a.x) * bflo(a.x) + bfhi(a.x) * bfhi(a.x)) + (bflo(a.y) * bflo(a.y) + bfhi(a.y) * bfhi(a.y)) + (bflo(a.z) * bflo(a.z) + bfhi(a.z) * bfhi(a.z)) + (bflo(a.w) * bflo(a.w) + bfhi(a.w) * bfhi(a.w));
            s += __shfl_xor(s, 1); s += __shfl_xor(s, 2); s += __shfl_xor(s, 4);
            if (c8 == 0) ssqv_w[8 * it] = s;
        }
        __syncthreads();
        if (tid < 128) { float s = 0.f;
#pragma unroll
            for (int w = 0; w < 8; ++w) s += SSQV[w * 128 + tid];
            RSV[tid] = 1.0f / sqrtf(s * (1.f / 512.f) + EPS); }
        __syncthreads();
#pragma unroll
        for (int it = 0; it < 16; ++it) {
            const float r = rsv_r[8 * it]; const v4u a = raw[it];
            v2u lo, hi; lo.x = pk2(bflo(a.x) * r, bfhi(a.x) * r); lo.y = pk2(bflo(a.y) * r, bfhi(a.y) * r); hi.x = pk2(bflo(a.z) * r, bfhi(a.z) * r); hi.y = pk2(bflo(a.w) * r, bfhi(a.w) * r);
            *(LAS v2u*)(vl_rc + it * 8 * VL_STRIDE) = lo; *(LAS v2u*)(vl_rc + it * 8 * VL_STRIDE + 4) = hi;
        }
        const int nitem = item + item_stride; const bool has_next = nitem < item_end;
        LDS_WAIT(); asm volatile("" ::: "memory");
        bf16x8 vf[8][2];
#pragma unroll
        for (int ks = 0; ks < 8; ++ks)
#pragma unroll
            for (int nb = 0; nb < 2; ++nb)
#pragma unroll
                for (int e = 0; e < 8; ++e) vf[ks][nb][e] = (short)VL[(16 * ks + 8 * kg + e) * VL_STRIDE + 32 * nb + il];
        LDS_WAIT(); asm volatile("" ::: "memory");
#pragma unroll
        for (int mb = 0; mb < 4; ++mb) {
            const int i = 32 * mb + il;
            const char* gub = (const char*)(PROJp + (t0 + 32 * mb) * PROJW + 1024 + 64 * h); unsigned vg = voff_gu, vw = voff_w, vv = (unsigned)(16 * kg); asm volatile("" : "+v"(vg), "+v"(vw), "+v"(vv));
            v2u gu[2][4];
#pragma unroll
            for (int nb = 0; nb < 2; ++nb)
#pragma unroll
                for (int blk = 0; blk < 4; ++blk) gu[nb][blk] = *(const v2u*)(gub + vg + (32 * nb + 8 * blk) * 2);
            f32x16 acc[2];
#pragma unroll
            for (int nb = 0; nb < 2; ++nb)
#pragma unroll
                for (int r = 0; r < 16; ++r) acc[nb][r] = 0.f;
            const char* wb = wbase + (size_t)(32 * mb) * 128 * 2;
#pragma unroll
            for (int ks = 0; ks < 2 * (mb + 1); ++ks) {
                const bf16x8 wf = *(const bf16x8*)(wb + vw + ks * 32);
                acc[0] = __builtin_amdgcn_mfma_f32_32x32x16_bf16(vf[ks][0], wf, acc[0], 0, 0, 0);
                acc[1] = __builtin_amdgcn_mfma_f32_32x32x16_bf16(vf[ks][1], wf, acc[1], 0, 0, 0);
            }
            const float bsv = bs[h * 128 + i];
            float ss = 0.f;
#pragma unroll
            for (int nb = 0; nb < 2; ++nb)
#pragma unroll
                for (int blk = 0; blk < 4; ++blk) {
                    const f32x4 vn = *(const f32x4*)(vnb + vv + (32 * nb + 8 * blk) * 4);
                    const float y0 = bflo(gu[nb][blk].x) * (acc[nb][4 * blk + 0] * vn.x + bsv), y1 = bfhi(gu[nb][blk].x) * (acc[nb][4 * blk + 1] * vn.y + bsv);
                    const float y2 = bflo(gu[nb][blk].y) * (acc[nb][4 * blk + 2] * vn.z + bsv), y3 = bfhi(gu[nb][blk].y) * (acc[nb][4 * blk + 3] * vn.w + bsv);
                    ss += (y0 * y0 + y1 * y1) + (y2 * y2 + y3 * y3);
                    v2u o; o.x = pk2(y0, y1); o.y = pk2(y2, y3);
                    *(LAS v2u*)(vl_id + 32 * mb * VL_STRIDE + 32 * nb + 8 * blk) = o;
                }
            ss += __shfl_xor(ss, 32);
            if (kg == 0) ssq2_w[32 * mb] = ss;
            asm volatile("" ::: "memory");
        }
        __syncthreads();
        const f32x4 g0 = *(const f32x4*)(gb + 64 * h + 8 * c8), g1 = *(const f32x4*)(gb + 64 * h + 8 * c8 + 4);
        float ta = 0.f, tb = 0.f;
#pragma unroll
        for (int w = 0; w < 8; ++w) { ta += SSQ2[w * 128 + lane]; tb += SSQ2[w * 128 + 64 + lane]; }
        rsw[lane] = 1.0f / sqrtf(ta * (1.f / 512.f) + EPS); rsw[64 + lane] = 1.0f / sqrtf(tb * (1.f / 512.f) + EPS);
        LDS_WAIT(); asm volatile("" ::: "memory");
        char* const yb = (char*)(Yp + t0 * DM + 512 + 64 * h); unsigned vy = voff_y; asm volatile("" : "+v"(vy));
#pragma unroll
        for (int it = 0; it < 16; ++it) {
            const float rs = (rsw + r8)[8 * it];
            const v2u lo = *(const LAS v2u*)(vl_rc + it * 8 * VL_STRIDE), hi = *(const LAS v2u*)(vl_rc + it * 8 * VL_STRIDE + 4);
            v4u o; o.x = pk2(bflo(lo.x) * rs * g0.x, bfhi(lo.x) * rs * g0.y); o.y = pk2(bflo(lo.y) * rs * g0.z, bfhi(lo.y) * rs * g0.w);
            o.z = pk2(bflo(hi.x) * rs * g1.x, bfhi(hi.x) * rs * g1.y); o.w = pk2(bflo(hi.y) * rs * g1.z, bfhi(hi.y) * rs * g1.w);
            *(v4u*)(yb + (size_t)it * (8 * DM * 2) + vy) = o;
            if ((it & 3) == 3) asm volatile("" ::: "memory");
        }
        if (!has_next) break;
        item = nitem;
    }
}

constexpr int NPHASE = 16;
__global__ void __launch_bounds__(NTHR, 2) fwd_megakernel(Params p) {
    extern __shared__ __attribute__((aligned(16))) unsigned char lds_raw[];
    LAS unsigned char* lds = (LAS unsigned char*)lds_raw;
    const int G = gridDim.x, NGW = G * NWAVES;
#define LANE_IDS() int tid_l = threadIdx.x; asm volatile("" : "+v"(tid_l)); const int tid = tid_l, lane = tid & 63, wave = __builtin_amdgcn_readfirstlane(tid >> 6), gw = blockIdx.x * NWAVES + wave; (void)lane; (void)gw; (void)tid; KARG_BASE()
    typedef const __attribute__((address_space(4))) unsigned long long* kargp_t;
#define KARG_BASE() kargp_t ka_ = (kargp_t)__builtin_amdgcn_kernarg_segment_ptr(); asm volatile("" : "+s"(ka_)); unsigned char* const ws = (unsigned char*)ka_[18]; (void)ws
#define PIN(i) ((const float*)ka_[i])
#define POUT ((float*)ka_[17])
#define MOD ((float*)(ws + WS_MOD))
#define H ((bf16*)(ws + WS_H))
#define PROJ ((bf16*)(ws + WS_PROJ))
#define Y ((bf16*)(ws + WS_Y))
#define ACT ((bf16*)(ws + WS_ACT))
#define X1 ((bf16*)(ws + WS_X1))
#ifdef DIAG_ONLY
#define IN(k) (((k) == DIAG_ONLY))
#else
#define IN(k) (true)
#endif
    if (threadIdx.x < 16) ((LAS unsigned*)(lds + MISC_OFF))[threadIdx.x] = 0u;
    __syncthreads();
    XcdBarrier bar; { KARG_BASE(); bar = xcd_barrier_post((unsigned*)(ws + WS_CTL), (volatile LAS unsigned*)(lds + MISC_OFF)); }
#ifndef PROBE_MASK
#define PROBE_MASK 0
#endif
#define REPS(k) for (int rep_ = 0; rep_ <= ((PROBE_MASK >> (k)) & 1); ++rep_)
#define REP_BAR() do { if (rep_) xcd_barrier(bar); } while (0)
#define SEAM(k) do { if (IN(k) && IN((k) + 1)) xcd_barrier(bar); } while (0)

    if (IN(0)) REPS(0) {
        REP_BAR();
        LANE_IDS();
        LAS float* scr = (LAS float*)(lds + wave * 16384);
        constexpr int I_IN = 16 * (NIN / 32), I_OUT = 16 * (DM / 32), I_UP = 16 * (NUP / 32), I_DN = (FF / 64) * (DM / 32), I_L = I_IN + I_OUT + I_UP + I_DN;
        for (int it = gw; it < DEPTH * I_L; it += NGW) {
            const int l = it / I_L; int r = it % I_L;
            if (r < I_IN) { transpose_item<1>(PIN(I_WIN) + (size_t)l * DM * NIN, DM, NIN, (bf16*)(ws + WS_WIN) + (size_t)l * NIN * DM, scr, r, lane); continue; } r -= I_IN;
            if (r < I_OUT) { transpose_item<0>(PIN(I_WOUT) + (size_t)l * DM * DM, DM, DM, (bf16*)(ws + WS_WOUT) + (size_t)l * DM * DM, scr, r, lane); continue; } r -= I_OUT;
            if (r < I_UP) { transpose_item<2>(PIN(I_WUP) + (size_t)l * DM * NUP, DM, NUP, (bf16*)(ws + WS_WUP) + (size_t)l * NUP * DM, scr, r, lane); continue; } r -= I_UP;
            transpose_item<0>(PIN(I_WDOWN) + (size_t)l * FF * DM, FF, DM, (bf16*)(ws + WS_WDN) + (size_t)l * DM * FF, scr, r, lane);
        }
        { bf16* Wsb = (bf16*)(ws + WS_WSB); const float* wsrc = PIN(I_WS);
          for (int e = blockIdx.x * NTHR + tid; e < DEPTH * 8 * 128 * 128; e += G * NTHR) { const int j = e & 127, i = (e >> 7) & 127; Wsb[e] = (bf16)(j <= i ? f2bf(wsrc[e]) : 0u); } }
        __syncthreads();
        for (int item = blockIdx.x; item < DEPTH * (NMOD / 64); item += G) {
            const int l = item / (NMOD / 64), col0 = (item % (NMOD / 64)) * 64;
            LAS float* cact = (LAS float*)lds;
            LAS float* red = (LAS float*)(lds + 65536);
            for (int idx = tid; idx < BATCH * DM; idx += NTHR) { const int b = idx >> 10, k = idx & 1023; const float cv = PIN(I_C)[idx]; cact[k * 16 + b] = cv / (1.0f + expf(-cv)); }
            __syncthreads();
            float a[16];
#pragma unroll
            for (int b = 0; b < 16; ++b) a[b] = 0.f;
            const float* wp = PIN(I_WMOD) + (size_t)l * DM * NMOD + (size_t)(wave * 128) * NMOD + col0 + lane;
            for (int k0 = 0; k0 < 128; k0 += 32) {
            float wv32[32];
#pragma unroll
            for (int kk = 0; kk < 32; ++kk) wv32[kk] = __builtin_nontemporal_load(wp + (size_t)(k0 + kk) * NMOD);
#pragma unroll
            for (int kk = 0; kk < 32; ++kk) { const int k = k0 + kk;
                const float wv = wv32[kk];
                const LAS f32x4* cr = (const LAS f32x4*)(cact + (wave * 128 + k) * 16);
                const f32x4 c0 = cr[0], c1 = cr[1], c2 = cr[2], c3 = cr[3];
                a[0] += c0.x * wv; a[1] += c0.y * wv; a[2] += c0.z * wv; a[3] += c0.w * wv; a[4] += c1.x * wv; a[5] += c1.y * wv; a[6] += c1.z * wv; a[7] += c1.w * wv;
                a[8] += c2.x * wv; a[9] += c2.y * wv; a[10] += c2.z * wv; a[11] += c2.w * wv; a[12] += c3.x * wv; a[13] += c3.y * wv; a[14] += c3.z * wv; a[15] += c3.w * wv;
            }
            }
#pragma unroll
            for (int b = 0; b < 16; ++b) red[(wave * 16 + b) * 64 + lane] = a[b];
            __syncthreads();
            for (int o = tid; o < 16 * 64; o += NTHR) { const int b = o >> 6, cc = o & 63; float s = PIN(I_BMOD)[l * NMOD + col0 + cc];
#pragma unroll
                for (int w = 0; w < 8; ++w) s += red[(w * 16 + b) * 64 + cc];
                MOD[((size_t)l * BATCH + b) * NMOD + col0 + cc] = s; }
            __syncthreads();
        }
    }
    xcd_barrier(bar);
    const unsigned cx_ = bar.x, cn_ = ((volatile LAS unsigned*)(lds + MISC_OFF))[0], cnx_ = ((volatile LAS unsigned*)(lds + MISC_OFF))[1], cr_ = ((volatile LAS unsigned*)(lds + MISC_OFF))[2];
    bool xlocal = (G == 256) && (cn_ == 32u) && (cnx_ == 8u) && (cx_ < 8u) && (cr_ < 32u);
    { KARG_BASE(); unsigned* cw = (unsigned*)(ws + WS_CTL);
#pragma unroll
      for (int j = 0; j < 8; ++j) xlocal = xlocal && (__builtin_amdgcn_readfirstlane((int)xb_ld(&cw[XB_XCNT(j)])) == 32); }
#ifdef FORCE_GRIDWIDE_SEAMS
    xlocal = false;
#endif
    const int vblk = xlocal ? (int)(cr_ * 8u + cx_) : (int)blockIdx.x;
    const int rbase = xlocal ? (int)cx_ * (M / 8) : 0, rspan = xlocal ? M / 8 : M;
    const int lblk = xlocal ? (int)cr_ : (int)blockIdx.x, LWAVES = xlocal ? 32 * NWAVES : NGW;
#undef SEAM
#define SEAM(k) do { if (xlocal) xcd_barrier_local(bar); else xcd_barrier(bar); } while (0)

#ifndef PROBE_LAYER
#define PROBE_LAYER 0
#endif
    for (int li = 0; li < DEPTH + PROBE_LAYER; ++li) {
        const int l = (li <= PROBE_LAYER) ? 0 : li - PROBE_LAYER;
        const int P = 1 + 7 * l;
#define modl (MOD + (size_t)l * BATCH * NMOD)
        if (IN(P + 0)) REPS(P + 0) { REP_BAR(); LANE_IDS(); if (l == 0) norm_phase(PIN(I_X), PIN(I_NMIX) + l * DM, modl, 0 * DM, 1 * DM, H, lblk * NWAVES + wave, LWAVES, rbase, rspan, lane); else norm_phase_b(X1, PIN(I_NMIX) + l * DM, modl, 0 * DM, 1 * DM, H, lblk * NWAVES + wave, LWAVES, rbase, rspan, lane); }
        SEAM(P + 0);
        if (IN(P + 1)) REPS(P + 1) {
            REP_BAR();
            KARG_BASE();
            pg8::Gemm g{H, (const bf16*)(ws + WS_WIN) + (size_t)l * NIN * DM, M, NIN, DM}; pg8::StaticOrder S; S.init(M, NIN, G, vblk);
            pg8::EpiProj E{PROJ};
            pg8::gemm_phase<pg8::EpiProj, pg8::StaticOrder, true, true>(lds, g, S, E);
        }
        SEAM(P + 1);
        if (IN(P + 2)) REPS(P + 2) {
            REP_BAR();
            LANE_IDS();
            sgu_phase(lds, PROJ, (const bf16*)(ws + WS_WSB) + (size_t)l * 8 * 128 * 128, PIN(I_VNORM) + l * 512, PIN(I_BS) + l * 8 * 128, PIN(I_ONB) + l * 512, Y, rbase / 128 + lblk, LWAVES / NWAVES, (rbase + rspan) / 128, tid, wave, lane);
            conv_phase(PROJ, PIN(I_CONVW) + l * 3 * 512, PIN(I_ONA) + l * 512, Y, lblk * NWAVES + wave, LWAVES, rbase, rspan, lane);
        }
        SEAM(P + 2);
        if (IN(P + 3)) REPS(P + 3) {
            REP_BAR();
            KARG_BASE();
            pg8::Gemm g{Y, (const bf16*)(ws + WS_WOUT) + (size_t)l * DM * DM, M, DM, DM}; pg8::StaticOrder S; S.init(M, DM, G, vblk);
            if (l == 0) { pg8::EpiResB<true> E{PIN(I_X), X1, modl + 2 * DM, NMOD}; pg8::gemm_phase<pg8::EpiResB<true>, pg8::StaticOrder, true, true>(lds, g, S, E); }
            else { pg8::EpiResB<false> E{X1, X1, modl + 2 * DM, NMOD}; pg8::gemm_phase<pg8::EpiResB<false>, pg8::StaticOrder, true, true>(lds, g, S, E); }
        }
        SEAM(P + 3);
        if (IN(P + 4)) REPS(P + 4) { REP_BAR(); LANE_IDS(); norm_phase_b(X1, PIN(I_NFFN) + l * DM, modl, 3 * DM, 4 * DM, H, lblk * NWAVES + wave, LWAVES, rbase, rspan, lane); }
        SEAM(P + 4);
        if (IN(P + 5)) REPS(P + 5) {
            REP_BAR();
            KARG_BASE();
            pg8::Gemm g{H, (const bf16*)(ws + WS_WUP) + (size_t)l * NUP * DM, M, NUP, DM}; pg8::StaticOrder S; S.init(M, NUP, G, vblk);
            pg8::EpiSwiGLU E{ACT, FF};
            pg8::gemm_phase<pg8::EpiSwiGLU, pg8::StaticOrder, true, true>(lds, g, S, E);
        }
        SEAM(P + 5);
        if (IN(P + 6)) REPS(P + 6) {
            REP_BAR();
            KARG_BASE();
            pg8::Gemm g{ACT, (const bf16*)(ws + WS_WDN) + (size_t)l * DM * FF, M, DM, FF}; pg8::StaticOrder S; S.init(M, DM, G, vblk);
            pg8::EpiResB<false> E{X1, X1, modl + 5 * DM, NMOD};
            pg8::gemm_phase<pg8::EpiResB<false>, pg8::StaticOrder, true, true>(lds, g, S, E);
        }
        SEAM(P + 6);
    }
    if (IN(15)) {
        LANE_IDS();
        constexpr int NR = 4;
        f32x4 g[2][2];
#pragma unroll
        for (int j = 0; j < 2; ++j) { g[j][0] = ((const f32x4*)PIN(I_NFINAL))[2 * (64 * j + lane)]; g[j][1] = ((const f32x4*)PIN(I_NFINAL))[2 * (64 * j + lane) + 1]; }
        const int lw = lblk * NWAVES + wave, LW = LWAVES;
        for (int u0 = lw * NR; u0 < rspan; u0 += LW * NR) { const int m0 = rbase + u0;
            v4u w[NR][2];
#pragma unroll
            for (int r = 0; r < NR; ++r)
#pragma unroll
                for (int j = 0; j < 2; ++j) w[r][j] = ((const v4u*)(X1 + (size_t)(m0 + r) * DM) + lane)[64 * j];
#pragma unroll
            for (int r = 0; r < NR; ++r) {
                f32x4 v[2][2]; float s = 0.f;
#pragma unroll
                for (int j = 0; j < 2; ++j) { const v4u ww = w[r][j];
                    v[j][0] = (f32x4){bflo(ww.x), bfhi(ww.x), bflo(ww.y), bfhi(ww.y)}; v[j][1] = (f32x4){bflo(ww.z), bfhi(ww.z), bflo(ww.w), bfhi(ww.w)};
#pragma unroll
                    for (int q = 0; q < 2; ++q) s += (v[j][q].x * v[j][q].x + v[j][q].y * v[j][q].y) + (v[j][q].z * v[j][q].z + v[j][q].w * v[j][q].w); }
                const float rs = 1.0f / sqrtf(wave_sum(s) * (1.f / DM) + EPS);
                f32x4* orow = (f32x4*)(POUT + (size_t)(m0 + r) * DM);
#pragma unroll
                for (int j = 0; j < 2; ++j)
#pragma unroll
                    for (int q = 0; q < 2; ++q) __builtin_nontemporal_store((v[j][q] * rs) * g[j][q], orow + 2 * (64 * j + lane) + q);
            }
        }
    }
#undef IN
#undef SEAM
}

#undef MOD
#undef H
#undef PROJ
#undef Y
#undef ACT
#undef X1
#undef modl
#undef xin
extern "C" void kernel_launch(void* const* d_in, const int* in_sizes, int n_in, void* d_out, int out_size, void* d_ws, size_t ws_size, hipStream_t stream) {
    static int grid = 0;
    if (grid == 0) {
        if (n_in != 17 || in_sizes[0] != M * DM || out_size != M * DM || ws_size < WS_END) { fprintf(stderr, "kernel_launch: unexpected shapes (n_in %d, in0 %d, out %d, ws %zu); nothing launched\n", n_in, n_in > 0 ? in_sizes[0] : -1, out_size, ws_size); grid = -1; return; }
        int dev = 0, cus = 0, per_cu = 0;
        hipGetDevice(&dev); hipDeviceGetAttribute(&cus, hipDeviceAttributeMultiprocessorCount, dev);
        if (hipFuncSetAttribute((const void*)fwd_megakernel, hipFuncAttributeMaxDynamicSharedMemorySize, LDS_BYTES) != hipSuccess) { fprintf(stderr, "kernel_launch: hipFuncSetAttribute failed\n"); grid = -1; return; }
        if (hipOccupancyMaxActiveBlocksPerMultiprocessor(&per_cu, (const void*)fwd_megakernel, NTHR, LDS_BYTES) != hipSuccess || per_cu < 1) { fprintf(stderr, "kernel_launch: occupancy query says %d blocks per CU; nothing launched\n", per_cu); (void)hipGetLastError(); grid = -1; return; }
        grid = cus * (per_cu > 1 ? 1 : per_cu);
    }
    if (grid < 0) return;
    if (hipMemsetAsync((char*)d_ws + WS_CTL, 0, CTL_BYTES, stream) != hipSuccess) { fprintf(stderr, "kernel_launch: hipMemsetAsync failed\n"); return; }
    Params p{};
    for (int i = 0; i < 17; ++i) p.in[i] = (const float*)d_in[i];
    p.out = (float*)d_out; p.ws = (unsigned char*)d_ws;
    p.ph_lo = 0; p.ph_hi = NPHASE;
    void* args[] = {&p};
    hipError_t e = hipLaunchCooperativeKernel((const void*)fwd_megakernel, dim3(grid), dim3(NTHR), args, LDS_BYTES, stream);
    if (e != hipSuccess) fprintf(stderr, "cooperative launch failed: %s (grid %d)\n", hipGetErrorString(e), grid);
}
```
